# Optimizing an MI355X kernel written in HIP

```python
import math
import jax, jax.numpy as jnp
from jax import lax
import numpy as np

D_MODEL = 1024
BATCH = 2
SEQ = 8192
DEPTH = 1
DEC_BATCH = 16
DEC_SEQ = 2048
PAST_LEN = 128

GRID_W = 64
ATT_HEADS = 8
ATT_HEAD_DIM = 64
D_ATT = ATT_HEADS * ATT_HEAD_DIM
WIN_ROWS = 8
WIN_COLS = 16
SSM_HEADS = 8
SSM_HEAD_DIM = 64
D_SSM = SSM_HEADS * SSM_HEAD_DIM
SSM_GROUPS = 2
D_STATE = 128
D_CONV = 5
CHUNK = 128
D_MIX = D_ATT + D_SSM
CONV_CH = D_SSM + 2 * SSM_GROUPS * D_STATE
D_IN_PROJ = 3 * D_ATT + D_SSM + CONV_CH + 2 * SSM_HEADS
D_FF = ((8 * D_MODEL + 3 * 256 - 1) // (3 * 256)) * 256
EPS = 1e-6

kernel_name = 'hymba_natten_ssd_encoder'


def rmsnorm(x, w):
    xf = x.astype(jnp.float32)
    y = xf * lax.rsqrt(jnp.mean(xf * xf, axis=-1, keepdims=True) + EPS)
    return (y * w.astype(jnp.float32)).astype(x.dtype)


def neighbourhood_attention(q, k, v, rpb):
    bsz, T, H, hd = q.shape
    rows = T // GRID_W
    wr = min(WIN_ROWS, rows)
    qg = q.reshape(bsz, rows, GRID_W, H, hd)
    kg = k.reshape(bsz, rows, GRID_W, H, hd)
    vg = v.reshape(bsz, rows, GRID_W, H, hd)
    cols = np.arange(GRID_W)
    c0 = np.clip(cols - WIN_COLS // 2, 0, GRID_W - WIN_COLS)
    col_idx = c0[:, None] + np.arange(WIN_COLS)[None, :]
    dc_idx = col_idx - cols[:, None] + (WIN_COLS - 1)
    rpb_c = rpb[:, :, dc_idx]

    def row_block(r):
        r0 = jnp.clip(r - WIN_ROWS // 2, 0, rows - wr)
        k_rows = lax.dynamic_slice_in_dim(kg, r0, wr, axis=1)
        v_rows = lax.dynamic_slice_in_dim(vg, r0, wr, axis=1)
        k_win = k_rows[:, :, col_idx]
        v_win = v_rows[:, :, col_idx]
        q_r = lax.dynamic_index_in_dim(qg, r, axis=1, keepdims=False)
        s = jnp.einsum('bqhd,brqchd->bhqrc', q_r, k_win).astype(jnp.float32)
        dr_idx = r0 - r + jnp.arange(wr) + (WIN_ROWS - 1)
        bias = jnp.take(rpb_c, dr_idx, axis=1).astype(jnp.float32)
        s = s + bias.transpose(0, 2, 1, 3)[None]
        p = jax.nn.softmax(s.reshape(bsz, H, GRID_W, wr * WIN_COLS), axis=-1)
        p = p.reshape(bsz, H, GRID_W, wr, WIN_COLS).astype(v.dtype)
        return jnp.einsum('bhqrc,brqchd->bqhd', p, v_win)

    out = lax.map(row_block, jnp.arange(rows))
    return out.transpose(1, 0, 2, 3, 4).reshape(bsz, T, H * hd)


def depthwise_conv(x, w, b):
    y = lax.conv_general_dilated(
        x, w[:, None, :], window_strides=(1,),
        padding=[(D_CONV // 2, D_CONV // 2)],
        dimension_numbers=('NWC', 'WIO', 'NWC'),
        feature_group_count=x.shape[-1])
    return y + b


def ssd_scan(x, dt, A, Bh, Ch):
    bsz, T, H, P = x.shape
    N = Bh.shape[-1]
    nc = T // CHUNK
    xdt = (x.astype(jnp.float32) * dt[..., None]).reshape(bsz, nc, CHUNK, H, P)
    Bc = Bh.astype(jnp.float32).reshape(bsz, nc, CHUNK, H, N)
    Cc = Ch.astype(jnp.float32).reshape(bsz, nc, CHUNK, H, N)
    a = (dt * A).reshape(bsz, nc, CHUNK, H).transpose(0, 3, 1, 2)
    a_cs = jnp.cumsum(a, axis=-1)
    tril = np.tril(np.ones((CHUNK, CHUNK), dtype=bool))
    seg = a_cs[..., :, None] - a_cs[..., None, :]
    Lmat = jnp.exp(jnp.where(tril, seg, -jnp.inf))
    cb = jnp.einsum('bclhn,bcshn->bhcls', Cc, Bc)
    y_diag = jnp.einsum('bhcls,bcshp->bclhp', cb * Lmat, xdt)
    decay_states = jnp.exp(a_cs[..., -1:] - a_cs)
    states = jnp.einsum('bclhn,bhcl,bclhp->bchpn', Bc, decay_states, xdt)
    chunk_decay = jnp.exp(a_cs[..., -1])

    def step(h, inp):
        s_c, d_c = inp
        return h * d_c[..., None, None] + s_c, h

    h0 = jnp.zeros((bsz, H, P, N), jnp.float32)
    _, prev = lax.scan(step, h0, (states.transpose(1, 0, 2, 3, 4), chunk_decay.transpose(2, 0, 1)))
    prev = prev.transpose(1, 0, 2, 3, 4)
    y_off = jnp.einsum('bclhn,bchpn,bhcl->bclhp', Cc, prev, jnp.exp(a_cs))
    return (y_diag + y_off).reshape(bsz, T, H, P)


def ssd_mixer(z, xBC, dt_f_raw, dt_b_raw, conv_w, conv_b, dt_bias_f, dt_bias_b,
              A_log_f, A_log_b, D_skip, ssm_norm_w):
    bsz, T, _ = z.shape
    xBC = jax.nn.silu(depthwise_conv(xBC, conv_w, conv_b))
    xs, Bm, Cm = jnp.split(xBC, [D_SSM, D_SSM + SSM_GROUPS * D_STATE], axis=-1)
    xs = xs.reshape(bsz, T, SSM_HEADS, SSM_HEAD_DIM)
    rep = SSM_HEADS // SSM_GROUPS
    Bh = jnp.repeat(Bm.reshape(bsz, T, SSM_GROUPS, D_STATE), rep, axis=2)
    Ch = jnp.repeat(Cm.reshape(bsz, T, SSM_GROUPS, D_STATE), rep, axis=2)
    dt_f = jax.nn.softplus(dt_f_raw.astype(jnp.float32) + dt_bias_f.astype(jnp.float32))
    dt_b = jax.nn.softplus(dt_b_raw.astype(jnp.float32) + dt_bias_b.astype(jnp.float32))
    A_f = -jnp.exp(A_log_f.astype(jnp.float32))
    A_b = -jnp.exp(A_log_b.astype(jnp.float32))
    y_f = ssd_scan(xs, dt_f, A_f, Bh, Ch)
    y_b = jnp.flip(ssd_scan(jnp.flip(xs, 1), jnp.flip(dt_b, 1), A_b,
                            jnp.flip(Bh, 1), jnp.flip(Ch, 1)), 1)
    y = y_f + y_b + D_skip.astype(jnp.float32)[:, None] * xs.astype(jnp.float32)
    g = y.reshape(bsz, T, D_SSM) * jax.nn.silu(z.astype(jnp.float32))
    g = g.reshape(bsz, T, SSM_GROUPS, D_SSM // SSM_GROUPS)
    g = g * lax.rsqrt(jnp.mean(g * g, axis=-1, keepdims=True) + EPS)
    g = g.reshape(bsz, T, D_SSM) * ssm_norm_w.astype(jnp.float32)
    return g.astype(z.dtype)


def hybrid_layer(x, norm1_w, w_in, q_norm_w, k_norm_w, rpb, conv_w, conv_b,
                 dt_bias_f, dt_bias_b, A_log_f, A_log_b, D_skip, ssm_norm_w,
                 w_out, norm2_w, w_gate, w_up, w_down):
    bsz, T, _ = x.shape
    h = rmsnorm(x, norm1_w)
    proj = h @ w_in
    splits = [D_ATT, 2 * D_ATT, 3 * D_ATT, 3 * D_ATT + D_SSM,
              3 * D_ATT + D_SSM + CONV_CH, 3 * D_ATT + D_SSM + CONV_CH + SSM_HEADS]
    q, k, v, z, xBC, dt_f, dt_b = jnp.split(proj, splits, axis=-1)
    q = rmsnorm(q.reshape(bsz, T, ATT_HEADS, ATT_HEAD_DIM), q_norm_w) * (ATT_HEAD_DIM ** -0.5)
    k = rmsnorm(k.reshape(bsz, T, ATT_HEADS, ATT_HEAD_DIM), k_norm_w)
    v = v.reshape(bsz, T, ATT_HEADS, ATT_HEAD_DIM)
    att = neighbourhood_attention(q, k, v, rpb)
    ssm = ssd_mixer(z, xBC, dt_f, dt_b, conv_w, conv_b, dt_bias_f, dt_bias_b,
                    A_log_f, A_log_b, D_skip, ssm_norm_w)
    x = x + jnp.concatenate([att, ssm], axis=-1) @ w_out
    h2 = rmsnorm(x, norm2_w)
    return x + (jax.nn.silu(h2 @ w_gate) * (h2 @ w_up)) @ w_down


def trunk(x, norm1_w, w_in, q_norm_w, k_norm_w, rpb, conv_w, conv_b,
          dt_bias_f, dt_bias_b, A_log_f, A_log_b, D_skip, ssm_norm_w,
          w_out, norm2_w, w_gate, w_up, w_down):
    for l in range(DEPTH):
        x = hybrid_layer(x, norm1_w[l], w_in[l], q_norm_w[l], k_norm_w[l], rpb[l],
                         conv_w[l], conv_b[l], dt_bias_f[l], dt_bias_b[l],
                         A_log_f[l], A_log_b[l], D_skip[l], ssm_norm_w[l],
                         w_out[l], norm2_w[l], w_gate[l], w_up[l], w_down[l])
    return x


def setup_inputs(seed: int = 0) -> dict:
    key = jax.random.key(seed)
    ks = jax.random.split(key, 24)
    f32 = jnp.float32
    L = DEPTH

    def nrm(k, shape, scale):
        return jax.random.normal(k, shape, f32) * scale

    def gain(k, shape):
        return 1.0 + 0.05 * jax.random.normal(k, shape, f32)

    def dt_bias(k):
        u = jax.random.uniform(k, (L, SSM_HEADS), f32)
        dt = jnp.exp(u * (math.log(0.1) - math.log(0.001)) + math.log(0.001))
        return dt + jnp.log(-jnp.expm1(-dt))

    return {
        'x_prompt': jax.random.normal(ks[0], (BATCH, SEQ, D_MODEL), f32),
        'x_sample': jax.random.normal(ks[1], (DEC_BATCH, DEC_SEQ, D_MODEL), f32),
        'norm1_w': gain(ks[2], (L, D_MODEL)),
        'w_in': nrm(ks[3], (L, D_MODEL, D_IN_PROJ), D_MODEL ** -0.5),
        'q_norm_w': gain(ks[4], (L, ATT_HEAD_DIM)),
        'k_norm_w': gain(ks[5], (L, ATT_HEAD_DIM)),
        'rpb': nrm(ks[6], (L, ATT_HEADS, 2 * WIN_ROWS - 1, 2 * WIN_COLS - 1), 0.1),
        'conv_w': nrm(ks[7], (L, D_CONV, CONV_CH), D_CONV ** -0.5),
        'conv_b': nrm(ks[8], (L, CONV_CH), 0.01),
        'dt_bias_f': dt_bias(ks[9]),
        'dt_bias_b': dt_bias(ks[10]),
        'A_log_f': jnp.log(jax.random.uniform(ks[11], (L, SSM_HEADS), f32, 1.0, 16.0)),
        'A_log_b': jnp.log(jax.random.uniform(ks[12], (L, SSM_HEADS), f32, 1.0, 16.0)),
        'D_skip': gain(ks[13], (L, SSM_HEADS)),
        'ssm_norm_w': gain(ks[14], (L, D_SSM)),
        'w_out': nrm(ks[15], (L, D_MIX, D_MODEL), D_MIX ** -0.5),
        'norm2_w': gain(ks[16], (L, D_MODEL)),
        'w_gate': nrm(ks[17], (L, D_MODEL, D_FF), D_MODEL ** -0.5),
        'w_up': nrm(ks[18], (L, D_MODEL, D_FF), D_MODEL ** -0.5),
        'w_down': nrm(ks[19], (L, D_FF, D_MODEL), D_FF ** -0.5),
    }


def reference(x_prompt, x_sample, norm1_w, w_in, q_norm_w, k_norm_w, rpb, conv_w, conv_b,
              dt_bias_f, dt_bias_b, A_log_f, A_log_b, D_skip, ssm_norm_w,
              w_out, norm2_w, w_gate, w_up, w_down):
    y_prompt = trunk(x_prompt, norm1_w, w_in, q_norm_w, k_norm_w, rpb, conv_w, conv_b,
                     dt_bias_f, dt_bias_b, A_log_f, A_log_b, D_skip, ssm_norm_w,
                     w_out, norm2_w, w_gate, w_up, w_down)
    y_sample = trunk(x_sample, norm1_w, w_in, q_norm_w, k_norm_w, rpb, conv_w, conv_b,
                     dt_bias_f, dt_bias_b, A_log_f, A_log_b, D_skip, ssm_norm_w,
                     w_out, norm2_w, w_gate, w_up, w_down)
    return (y_prompt, y_sample)
```

```cpp
#include <hip/hip_runtime.h>
#include <hip/hip_cooperative_groups.h>
#include <cstdio>
#include <cstdint>
namespace cg = cooperative_groups;
namespace pg8 {
#define PG8_LAS __attribute__((address_space(3)))
typedef unsigned short bf16_t;
typedef short bf16x8 __attribute__((ext_vector_type(8)));
typedef float f32x4 __attribute__((ext_vector_type(4)));
typedef unsigned u32x4 __attribute__((ext_vector_type(4)));
constexpr int BM = 256, BK = 64, HALF = 128, HTB = HALF * BK * 2  , STAGE_BYTES = 8 * HTB, NXCD = 8, WGM = 4;

__host__ __device__ __forceinline__ int lds_byte(int r, int c) { const int st = (r >> 4) * 2 + (c >> 5), rr = r & 15, cc = c & 31, ob = rr * 64 + cc * 2; return st * 1024 + (ob ^ (((ob >> 9) & 1) << 5)); }
__host__ __device__ __forceinline__ void stage_rc(int b, int& R, int& C) { const int st = b / 1024, sb = b % 1024, swz = sb ^ (((sb >> 9) & 1) << 5); R = (st >> 1) * 16 + swz / 64; C = (st & 1) * 32 + (swz % 64) / 2; }
__host__ __device__ __forceinline__ int perm32(int rho) { const int n = rho >> 4, i = rho & 15; return 8 * (i >> 2) + 4 * n + (i & 3); }

struct Unit { int pm, pn; };
struct Gemm { const bf16_t* A; const bf16_t* Bt; int M, N, K; };

struct StaticOrder {
    int nM, nN, nwg, G, c;
    __host__ __device__ void init(int M, int N, int G_, int c_) { nM = M / BM; nN = N / BM; nwg = nM * nN; G = G_; c = c_; }
    __host__ __device__ bool next(int i, Unit& u) const {
        const long L = (long)i * G + c; if (L >= nwg) return false;
        int wgid = (int)L; { const int q = nwg / NXCD, r = nwg % NXCD, xcd = wgid % NXCD, off = wgid / NXCD; wgid = (xcd < r ? xcd * (q + 1) : r * (q + 1) + (xcd - r) * q) + off; }
        const int nig = WGM * nN, gid = wgid / nig, fm = gid * WGM, gsz = (nM - fm) < WGM ? (nM - fm) : WGM;
        u.pm = fm + ((wgid % nig) % gsz); u.pn = (wgid % nig) / gsz; return true;
    }
    __device__ __forceinline__ void a_ready(const Unit&) const {}
    __device__ __forceinline__ void done(const Unit&) const {}
};

__device__ __forceinline__ unsigned cvt_pk_bf16(float lo, float hi) { unsigned r; asm volatile("v_cvt_pk_bf16_f32 %0, %1, %2" : "=v"(r) : "v"(lo), "v"(hi)); return r; }
template <class Epi, class Sched, bool ALIGN_EPI = false, bool SP2 = false>
__device__ __forceinline__ void gemm_phase(PG8_LAS unsigned char* lds, const Gemm g, const Sched& S, const Epi& E) {
    const int tid = threadIdx.x, wid = __builtin_amdgcn_readfirstlane(tid >> 6), lane = tid & 63, wr = wid >> 2, wc = wid & 3, fr = lane & 15, fq = lane >> 4;
    const int K = g.K, nt = K / BK;
    unsigned voffA[2], voffB[2];
#pragma unroll
    for (int i = 0; i < 2; ++i) { int R, C; stage_rc(tid * 16 + i * 8192, R, C); const int Rb = Epi::PERM ? ((R & ~31) + perm32(R & 31)) : R;
        voffA[i] = (unsigned)(R * K + C) * 2u; voffB[i] = (unsigned)(Rb * K + C) * 2u; }
    const size_t kstep = (size_t)(BK * 2);
    const size_t hstep = (size_t)HALF * K * 2;
    const size_t tstep = 2 * hstep;
    const unsigned ldsw = (unsigned)wid * 1024u;
    const int aoff = lds_byte(wr * 64 + fr, fq * 8), boff = lds_byte(wc * 32 + fr, fq * 8);
#define PG8_SA(b, h) (((b) * 2 + (h)) * HTB)
#define PG8_SB(b, h) ((4 + (b) * 2 + (h)) * HTB)
#define PG8_STAGE(bufoff, gbase, voff) do { _Pragma("unroll") for (int _i = 0; _i < 2; ++_i) \
        __builtin_amdgcn_global_load_lds((const unsigned*)((const char*)(gbase) + (voff)[_i]), (PG8_LAS unsigned*)(lds + (bufoff) + ldsw + _i * 8192), 16, 0, 0); } while (0)
#define PG8_LDA(dst, b, h) do { _Pragma("unroll") for (int m = 0; m < 4; ++m) _Pragma("unroll") for (int k = 0; k < 2; ++k) dst[m][k] = *(const PG8_LAS bf16x8*)(lds + PG8_SA(b, h) + aoff + m * 2048 + k * 1024); } while (0)
#define PG8_LDB(dst, b, h) do { _Pragma("unroll") for (int n = 0; n < 2; ++n) _Pragma("unroll") for (int k = 0; k < 2; ++k) dst[n][k] = *(const PG8_LAS bf16x8*)(lds + PG8_SB(b, h) + boff + n * 2048 + k * 1024); } while (0)
#define PG8_MMA(ai, bj, At, Bt) do { __builtin_amdgcn_s_setprio(1); _Pragma("unroll") for (int m = 0; m < 4; ++m) _Pragma("unroll") for (int n = 0; n < 2; ++n) _Pragma("unroll") for (int k = 0; k < 2; ++k) \
        acc[ai][bj][m][n] = __builtin_amdgcn_mfma_f32_16x16x32_bf16(Bt[n][k], At[m][k], acc[ai][bj][m][n], 0, 0, 0); __builtin_amdgcn_s_setprio(0); } while (0)
#define PG8_WAIT_V(n) asm volatile("s_waitcnt vmcnt(" #n ")" ::: "memory")
#define PG8_WAIT_L(n) asm volatile("s_waitcnt lgkmcnt(" #n ")" ::: "memory")
#define PG8_BAR __builtin_amdgcn_s_barrier()
#define PG8_SCHED __builtin_amdgcn_sched_barrier(0)
    Unit cur, nxt; int ui = 0;
    if (!S.next(0, cur)) return;
    f32x4 acc[2][2][4][2];
#pragma unroll
    for (int a = 0; a < 2; ++a)
#pragma unroll
        for (int b = 0; b < 2; ++b)
#pragma unroll
            for (int m = 0; m < 4; ++m)
#pragma unroll
                for (int n = 0; n < 2; ++n) acc[a][b][m][n] = (f32x4){0.f, 0.f, 0.f, 0.f};
    bf16x8 At[4][2], B0[2][2], B1[2][2];
    const char* cA = (const char*)g.A + (size_t)cur.pm * tstep; const char* cB = (const char*)g.Bt + (size_t)cur.pn * tstep;
    S.a_ready(cur);
    if constexpr (SP2) {
        PG8_STAGE(PG8_SB(0, 0), cB, voffB); PG8_STAGE(PG8_SB(0, 1), cB + hstep, voffB); PG8_STAGE(PG8_SA(0, 0), cA, voffA); PG8_STAGE(PG8_SA(0, 1), cA + hstep, voffA);
        if (wr == 1) PG8_BAR;
        PG8_WAIT_V(2); PG8_BAR;
        PG8_STAGE(PG8_SB(1, 0), cB + kstep, voffB); PG8_STAGE(PG8_SA(1, 0), cA + kstep, voffA); PG8_STAGE(PG8_SB(1, 1), cB + hstep + kstep, voffB);
        PG8_WAIT_V(6); PG8_BAR;
    } else {
        PG8_STAGE(PG8_SB(0, 0), cB, voffB); PG8_STAGE(PG8_SA(0, 0), cA, voffA); PG8_STAGE(PG8_SB(0, 1), cB + hstep, voffB); PG8_STAGE(PG8_SA(0, 1), cA + hstep, voffA);
        if (wr == 1) PG8_BAR;
        PG8_WAIT_V(4); PG8_BAR;
        PG8_STAGE(PG8_SB(1, 0), cB + kstep, voffB); PG8_STAGE(PG8_SA(1, 0), cA + kstep, voffA); PG8_STAGE(PG8_SB(1, 1), cB + hstep + kstep, voffB);
        PG8_WAIT_V(6); PG8_BAR;
    }
    for (;;) {
        const bool has_next = S.next(ui + 1, nxt);
        const char* nA = has_next ? (const char*)g.A + (size_t)nxt.pm * tstep : cA; const char* nB = has_next ? (const char*)g.Bt + (size_t)nxt.pn * tstep : cB;
        for (int t = 0; t < nt; t += 2) {
            const bool last = (t == nt - 2);
            const char* a1 = cA + (size_t)(t + 1) * kstep;
            const char* a2 = last ? nA : cA + (size_t)(t + 2) * kstep; const char* b2 = last ? nB : cB + (size_t)(t + 2) * kstep;
            const char* a3 = a2 + kstep; const char* b3 = b2 + kstep;
            if (last && has_next) S.a_ready(nxt);
            if constexpr (SP2) {
            PG8_LDB(B0, 0, 0); PG8_LDB(B1, 0, 1); PG8_SCHED; PG8_LDA(At, 0, 0); PG8_STAGE(PG8_SA(1, 1), a1 + hstep, voffA);
            PG8_WAIT_V(8); PG8_WAIT_L(0); PG8_BAR; PG8_MMA(0, 0, At, B0); PG8_MMA(0, 1, At, B1); PG8_BAR; PG8_SCHED;
            PG8_LDA(At, 0, 1); PG8_STAGE(PG8_SB(0, 0), b2, voffB); PG8_STAGE(PG8_SB(0, 1), b2 + hstep, voffB); PG8_STAGE(PG8_SA(0, 0), a2, voffA);
            PG8_WAIT_V(8); PG8_WAIT_L(0); PG8_BAR; PG8_MMA(1, 0, At, B0); PG8_MMA(1, 1, At, B1); PG8_BAR; PG8_SCHED;
            PG8_LDB(B0, 1, 0); PG8_LDB(B1, 1, 1); PG8_SCHED; PG8_LDA(At, 1, 0); PG8_STAGE(PG8_SA(0, 1), a2 + hstep, voffA);
            PG8_WAIT_V(8); PG8_WAIT_L(0); PG8_BAR; PG8_MMA(0, 0, At, B0); PG8_MMA(0, 1, At, B1); PG8_BAR; PG8_SCHED;
            PG8_LDA(At, 1, 1); PG8_STAGE(PG8_SB(1, 0), b3, voffB); PG8_STAGE(PG8_SB(1, 1), b3 + hstep, voffB); PG8_STAGE(PG8_SA(1, 0), a3, voffA);
            PG8_WAIT_V(8); PG8_WAIT_L(0); PG8_BAR; PG8_MMA(1, 0, At, B0); PG8_MMA(1, 1, At, B1); PG8_BAR; PG8_SCHED;
            } else {
            PG8_LDB(B0, 0, 0); PG8_SCHED; PG8_LDA(At, 0, 0); PG8_STAGE(PG8_SA(1, 1), a1 + hstep, voffA);
            PG8_WAIT_L(8); PG8_BAR; PG8_WAIT_L(0); PG8_MMA(0, 0, At, B0); PG8_BAR; PG8_SCHED;
            PG8_LDB(B1, 0, 1); PG8_STAGE(PG8_SB(0, 0), b2, voffB);
            PG8_BAR; PG8_WAIT_L(0); PG8_MMA(0, 1, At, B1); PG8_BAR;
            PG8_LDA(At, 0, 1); PG8_STAGE(PG8_SA(0, 0), a2, voffA);
            PG8_BAR; PG8_WAIT_L(0); PG8_MMA(1, 0, At, B0); PG8_BAR; PG8_SCHED;
            PG8_STAGE(PG8_SB(0, 1), b2 + hstep, voffB);
            PG8_WAIT_V(6); PG8_BAR; PG8_MMA(1, 1, At, B1); PG8_BAR;
            PG8_LDB(B0, 1, 0); PG8_SCHED; PG8_LDA(At, 1, 0); PG8_STAGE(PG8_SA(0, 1), a2 + hstep, voffA);
            PG8_WAIT_L(8); PG8_BAR; PG8_WAIT_L(0); PG8_MMA(0, 0, At, B0); PG8_BAR; PG8_SCHED;
            PG8_LDB(B1, 1, 1); PG8_STAGE(PG8_SB(1, 0), b3, voffB);
            PG8_BAR; PG8_WAIT_L(0); PG8_MMA(0, 1, At, B1); PG8_BAR;
            PG8_LDA(At, 1, 1); PG8_STAGE(PG8_SA(1, 0), a3, voffA);
            PG8_BAR; PG8_WAIT_L(0); PG8_MMA(1, 0, At, B0); PG8_BAR; PG8_SCHED;
            PG8_STAGE(PG8_SB(1, 1), b3 + hstep, voffB);
            PG8_WAIT_V(6); PG8_BAR; PG8_MMA(1, 1, At, B1); PG8_BAR;
            }
        }
        if constexpr (ALIGN_EPI) { if (wr == 0) PG8_BAR; }
        if constexpr (!Epi::AFTER_DRAIN) { E(acc, cur, wr, wc, fr, fq); S.done(cur); }
        if (!has_next) break;
#pragma unroll
        for (int a = 0; a < 2; ++a)
#pragma unroll
            for (int b = 0; b < 2; ++b)
#pragma unroll
                for (int m = 0; m < 4; ++m)
#pragma unroll
                    for (int n = 0; n < 2; ++n) acc[a][b][m][n] = (f32x4){0.f, 0.f, 0.f, 0.f};
        cur = nxt; cA = nA; cB = nB; ++ui;
        if constexpr (ALIGN_EPI) { if (wr == 1) PG8_BAR; }
    }
    PG8_WAIT_V(0);
    if constexpr (!ALIGN_EPI) { if (wr == 0) PG8_BAR; }
    PG8_BAR;
    if constexpr (Epi::AFTER_DRAIN) { E.fused(acc, cur, wr, wc, fr, fq, lds, wid, lane); S.done(cur); }
#undef PG8_SA
#undef PG8_SB
#undef PG8_STAGE
#undef PG8_LDA
#undef PG8_LDB
#undef PG8_MMA
#undef PG8_WAIT_V
#undef PG8_WAIT_L
#undef PG8_BAR
#undef PG8_SCHED
}
}
namespace hk {
typedef unsigned short bf16;
typedef short bf16x8 __attribute__((ext_vector_type(8)));
typedef float f32x4 __attribute__((ext_vector_type(4)));
typedef unsigned u32x4 __attribute__((ext_vector_type(4)));
typedef unsigned u32x2 __attribute__((ext_vector_type(2)));

constexpr int M = 49152, MP = 16384;
constexpr float EPS = 1e-6f;
constexpr size_t MiB = 1u << 20;
constexpr size_t WS_PART = 29 * MiB;
constexpr size_t WS_CDEC = 0;
constexpr size_t WS_BAR = 800 * 1024;
constexpr size_t WS_DT = 1 * MiB;
constexpr size_t WS_WIN = 4 * MiB, WS_WOUT = 10 * MiB, WS_WGU = 12 * MiB, WS_WDN = 23 * MiB;
constexpr size_t WS_XN = 32 * MiB;
constexpr size_t WS_QK = 128 * MiB, WS_VZ = 224 * MiB, WS_XBC = 320 * MiB;
constexpr size_t WS_HID = 128 * MiB;
constexpr size_t WS_MIX = 416 * MiB;
constexpr size_t WS_END = 512 * MiB;
constexpr size_t DO_XT = 0, DO_BROW = 48 * MiB, DO_BT = 72 * MiB, DO_CROW = 96 * MiB, DO_VT = 120 * MiB;

struct Params { const float* in[20]; float* out; unsigned char* ws; };

__device__ __forceinline__ float bf2f(unsigned v) { return __uint_as_float(v << 16); }
typedef float f32x2_t __attribute__((ext_vector_type(2))); typedef __bf16 bf16x2_t __attribute__((ext_vector_type(2)));
__device__ __forceinline__ unsigned pk2c(float lo, float hi) { f32x2_t v = {lo, hi}; bf16x2_t b = __builtin_convertvector(v, bf16x2_t); return __builtin_bit_cast(unsigned, b); }
__device__ __forceinline__ unsigned pk2(float lo, float hi) { return pg8::cvt_pk_bf16(lo, hi); }
__device__ __forceinline__ unsigned short f2bf(float f) { return (unsigned short)(pk2(f, 0.f) & 0xffffu); }
__device__ __forceinline__ f32x4 mfma16(bf16x8 a, bf16x8 b, f32x4 c) { return __builtin_amdgcn_mfma_f32_16x16x32_bf16(a, b, c, 0, 0, 0); }
__device__ __forceinline__ float wave_sum(float v) {
#pragma unroll
    for (int o = 1; o < 64; o <<= 1) v += __shfl_xor(v, o);
    return v;
}
__device__ __forceinline__ float silu(float x) { return x * __builtin_amdgcn_rcpf(1.f + __expf(-x)); }
__device__ __forceinline__ bf16x8 pack8(const float (&f)[8]) {
    u32x4 w; w.x = pk2(f[0], f[1]); w.y = pk2(f[2], f[3]); w.z = pk2(f[4], f[5]); w.w = pk2(f[6], f[7]);
    return __builtin_bit_cast(bf16x8, w);
}
__device__ __forceinline__ bf16x8 pack8m(const float (&f)[8]) {
    u32x4 w; w.x = pk2c(f[0], f[1]); w.y = pk2c(f[2], f[3]); w.z = pk2c(f[4], f[5]); w.w = pk2c(f[6], f[7]);
    return __builtin_bit_cast(bf16x8, w);
}
#define LDS_WAIT() asm volatile("s_waitcnt lgkmcnt(0)" ::: "memory")
__device__ __forceinline__ void mfma_operand_pad(bf16x8& f) { asm volatile("s_nop 7" : "+v"(f)); }

__device__ __forceinline__ void wave_scan2(float a0, float a1, int lane, float& p0, float& p1, float& tot) {
    const float s = a0 + a1; float inc = s;
#pragma unroll
    for (int o = 1; o < 64; o <<= 1) { const float t = __shfl_up(inc, o); if (lane >= o) inc += t; }
    const float excl = inc - s;
    p0 = excl + a0; p1 = p0 + a1; tot = __shfl(inc, 63);
}

__device__ __forceinline__ void tr_item(const float* __restrict__ W, int ldw, int K, int col0, bf16* WT, int dstrow0, const float* __restrict__ kscale, float* scr, int k0, int lane) {
#pragma unroll 8
    for (int i = 0; i < 32; ++i) { const int kk = 2 * i + (lane >> 5); scr[kk * 33 + (lane & 31)] = W[(size_t)(k0 + kk) * ldw + col0 + (lane & 31)]; }
    LDS_WAIT();
    const int c = lane & 7;
    float ks[8];
#pragma unroll
    for (int i = 0; i < 8; ++i) ks[i] = kscale ? kscale[k0 + 8 * c + i] : 1.f;
#pragma unroll
    for (int j = 0; j < 4; ++j) { const int n = (lane >> 3) + 8 * j; const float* s = scr + (8 * c) * 33 + n;
        u32x4 o; o.x = pk2(s[0 * 33] * ks[0], s[1 * 33] * ks[1]); o.y = pk2(s[2 * 33] * ks[2], s[3 * 33] * ks[3]);
        o.z = pk2(s[4 * 33] * ks[4], s[5 * 33] * ks[5]); o.w = pk2(s[6 * 33] * ks[6], s[7 * 33] * ks[7]);
        *(u32x4*)(WT + (size_t)(dstrow0 + n) * K + k0 + 8 * c) = o; }
    LDS_WAIT();
}

__device__ __forceinline__ void phase0(const Params& p, unsigned char* lds, int tid, int lane, int wave, int G) {
    const int gw = blockIdx.x * 8 + wave, NGW = G * 8;
    float* scr = (float*)(lds + 65536 + wave * 8448);
    const float* norm1_w = p.in[2]; const float* w_in = p.in[3]; const float* w_out = p.in[15]; const float* norm2_w = p.in[16];
    const float* w_gate = p.in[17]; const float* w_up = p.in[18]; const float* w_down = p.in[19];
    bf16* Win_t = (bf16*)(p.ws + WS_WIN); bf16* Wout_t = (bf16*)(p.ws + WS_WOUT); bf16* Wgu_t = (bf16*)(p.ws + WS_WGU); bf16* Wdn_t = (bf16*)(p.ws + WS_WDN);
    constexpr int I_IN = 16 * 96, I_OUT = 16 * 32, I_G = 16 * 88, I_DN = 44 * 32, NIT = I_IN + I_OUT + 2 * I_G + I_DN;
    for (int it = gw; it < NIT; it += NGW) {
        int r = it;
        if (r < I_IN) { const int kb = r / 96, nb = r % 96; tr_item(w_in, 3088, 1024, nb * 32, Win_t, nb * 32, norm1_w, scr, kb * 64, lane); continue; } r -= I_IN;
        if (r < I_OUT) { const int kb = r / 32, nb = r % 32; tr_item(w_out, 1024, 1024, nb * 32, Wout_t, nb * 32, nullptr, scr, kb * 64, lane); continue; } r -= I_OUT;
        if (r < I_G) { const int kb = r / 88, nb = r % 88, c0 = nb * 32; tr_item(w_gate, 2816, 1024, c0, Wgu_t, (c0 >> 7) * 256 + (c0 & 127), norm2_w, scr, kb * 64, lane); continue; } r -= I_G;
        if (r < I_G) { const int kb = r / 88, nb = r % 88, c0 = nb * 32; tr_item(w_up, 2816, 1024, c0, Wgu_t, (c0 >> 7) * 256 + 128 + (c0 & 127), norm2_w, scr, kb * 64, lane); continue; } r -= I_G;
        { const int kb = r / 32, nb = r % 32; tr_item(w_down, 1024, 2816, nb * 32, Wdn_t, nb * 32, nullptr, scr, kb * 64, lane); }
    }
    float* wdt = (float*)lds;
    for (int idx = tid; idx < 16384; idx += 512) { const int col = idx >> 4, o = idx & 15; wdt[o * 1024 + col] = w_in[(size_t)col * 3088 + 3072 + o] * norm1_w[col]; }
    __syncthreads();
    const float* xp = p.in[0]; const float* xs = p.in[1]; const float* dtbf = p.in[9]; const float* dtbb = p.in[10];
    bf16* XN = (bf16*)(p.ws + WS_XN); float* DT = (float*)(p.ws + WS_DT);
    f32x4 vn[4];
    { const float* xr = gw < MP ? xp + (size_t)gw * 1024 : xs + (size_t)(gw - MP) * 1024;
#pragma unroll
        for (int j = 0; j < 4; ++j) vn[j] = ((const f32x4*)xr)[64 * j + lane]; }
    const int oidx = ((lane >> 5) & 1) * 8 + ((lane >> 4) & 1) * 4 + ((lane >> 3) & 1) * 2 + ((lane >> 2) & 1);
    const float obias = oidx < 8 ? dtbf[oidx] : dtbb[oidx - 8];
    for (int row = gw; row < M; row += NGW) {
        f32x4 v[4]; float ss = 0.f;
#pragma unroll
        for (int j = 0; j < 4; ++j) { v[j] = vn[j]; ss += (v[j].x * v[j].x + v[j].y * v[j].y) + (v[j].z * v[j].z + v[j].w * v[j].w); }
        { const int nrow = row + NGW;
            if (nrow < M) { const float* xr = nrow < MP ? xp + (size_t)nrow * 1024 : xs + (size_t)(nrow - MP) * 1024;
#pragma unroll
                for (int j = 0; j < 4; ++j) vn[j] = ((const f32x4*)xr)[64 * j + lane]; } }
        const float rstd = rsqrtf(wave_sum(ss) * (1.f / 1024.f) + EPS);
#pragma unroll
        for (int j = 0; j < 4; ++j) { v[j] = v[j] * rstd; u32x2 o; o.x = pk2(v[j].x, v[j].y); o.y = pk2(v[j].z, v[j].w); ((u32x2*)(XN + (size_t)row * 1024))[64 * j + lane] = o; }
        float part[16];
#pragma unroll
        for (int o = 0; o < 16; ++o) { float acc = 0.f;
#pragma unroll
            for (int j = 0; j < 4; ++j) { const f32x4 w = *(const f32x4*)(wdt + o * 1024 + 256 * j + 4 * lane); acc += (v[j].x * w.x + v[j].y * w.y) + (v[j].z * w.z + v[j].w * w.w); }
            part[o] = acc; }
        float r8[8], r4[4], r2[2];
#pragma unroll
        for (int o = 0; o < 8; ++o) { const bool hi = (lane & 32) != 0; const float send = hi ? part[o] : part[o + 8], keep = hi ? part[o + 8] : part[o]; r8[o] = keep + __shfl_xor(send, 32); }
#pragma unroll
        for (int o = 0; o < 4; ++o) { const bool hi = (lane & 16) != 0; const float send = hi ? r8[o] : r8[o + 4], keep = hi ? r8[o + 4] : r8[o]; r4[o] = keep + __shfl_xor(send, 16); }
#pragma unroll
        for (int o = 0; o < 2; ++o) { const bool hi = (lane & 8) != 0; const float send = hi ? r4[o] : r4[o + 2], keep = hi ? r4[o + 2] : r4[o]; r2[o] = keep + __shfl_xor(send, 8); }
        float r1; { const bool hi = (lane & 4) != 0; const float send = hi ? r2[0] : r2[1], keep = hi ? r2[1] : r2[0]; r1 = keep + __shfl_xor(send, 4); }
        r1 += __shfl_xor(r1, 1); r1 += __shfl_xor(r1, 2);
        if ((lane & 3) == 0) { const float x = r1 + obias; DT[(size_t)row * 16 + oidx] = fmaxf(x, 0.f) + log1pf(__expf(-fabsf(x))); }
    }
}

__device__ __forceinline__ void conv_load(const Params& p, int u, int tid, bf16x8 (&pre)[3], float& wpre) {
    const int c = u >> 4, sb = u & 15, t0 = c * 128;
    wpre = 0.f; if (tid < 320) wpre = p.in[7][(tid >> 6) * 1024 + sb * 64 + (tid & 63)]; else if (tid < 384) wpre = p.in[8][sb * 64 + (tid - 320)];
    const bool first = (c < 128) ? ((c & 63) == 0) : (((c - 128) & 15) == 0);
    const bool last = (c < 128) ? ((c & 63) == 63) : (((c - 128) & 15) == 15);
    const bf16* XBC = (const bf16*)(p.ws + WS_XBC);
#pragma unroll
    for (int k = 0; k < 3; ++k) { const int idx = tid + 512 * k; const int rr = idx >> 3, seg = idx & 7; const int t = t0 - 2 + rr;
        const bool ok = (idx < 132 * 8) && (rr >= 2 || !first) && (rr < 130 || !last);
        bf16x8 v = {0, 0, 0, 0, 0, 0, 0, 0}; if (ok) v = *(const bf16x8*)(XBC + (size_t)t * 1024 + sb * 64 + seg * 8);
        pre[k] = v; }
}
__device__ __forceinline__ void conv_unit(const Params& p, unsigned char* lds, int u, int unext, int tid, bf16x8 (&pre)[3], float& wpre) {
    const int c = u >> 4, sb = u & 15, t0 = c * 128;
    float* raw = (float*)lds;
#pragma unroll
    for (int k = 0; k < 3; ++k) { const int idx = tid + 512 * k; const int rr = idx >> 3, seg = idx & 7;
        if (idx < 132 * 8) {
#pragma unroll
            for (int j = 0; j < 8; ++j) raw[rr * 65 + seg * 8 + j] = bf2f((unsigned short)pre[k][j]); } }
    float* wl = raw + 132 * 65;
    if (tid < 384) wl[tid] = wpre;
    __syncthreads();
    if (unext < 384 * 16) conv_load(p, unext, tid, pre, wpre);
    unsigned char* dout = (unsigned char*)p.out;
    {
        const int ch = tid & 63, l0 = (tid >> 6) * 16;
        const float w0 = wl[ch], w1 = wl[64 + ch], w2 = wl[128 + ch], w3 = wl[192 + ch], w4 = wl[256 + ch], b = wl[320 + ch];
        float rv[20];
#pragma unroll
        for (int k = 0; k < 20; ++k) rv[k] = raw[(l0 + k) * 65 + ch];
        float ov[16];
#pragma unroll
        for (int j = 0; j < 16; ++j) ov[j] = silu(b + rv[j] * w0 + rv[j + 1] * w1 + rv[j + 2] * w2 + rv[j + 3] * w3 + rv[j + 4] * w4);
        if (sb >= 8) {
            bf16* dst = ((sb < 12) ? (bf16*)(dout + DO_BROW) + (sb - 8) * 64 + ch : (bf16*)(dout + DO_CROW) + (sb - 12) * 64 + ch) + (size_t)(t0 + l0) * 256;
#pragma unroll
            for (int j = 0; j < 16; ++j) dst[(size_t)j * 256] = f2bf(ov[j]);
        }
        if (sb < 12) {
            bf16* dstT = ((sb < 8) ? (bf16*)(dout + DO_XT) + (size_t)(c * 8 + sb) * 8192 + ch * 128
                                   : (bf16*)(dout + DO_BT) + ((size_t)(c * 2 + ((sb - 8) >> 1)) * 128 + ((sb - 8) & 1) * 64 + ch) * 128) + l0;
            u32x4 o0, o1;
            o0.x = pk2(ov[0], ov[1]); o0.y = pk2(ov[2], ov[3]); o0.z = pk2(ov[4], ov[5]); o0.w = pk2(ov[6], ov[7]);
            o1.x = pk2(ov[8], ov[9]); o1.y = pk2(ov[10], ov[11]); o1.z = pk2(ov[12], ov[13]); o1.w = pk2(ov[14], ov[15]);
            *(u32x4*)dstT = o0; *(u32x4*)(dstT + 8) = o1;
        }
    }
    __syncthreads();
}

__device__ __forceinline__ void phase2(const Params& p, unsigned char* lds, int tid, int lane, int wave, int G) {
    { bf16x8 pre[3]; float wpre; conv_load(p, blockIdx.x, tid, pre, wpre);
      for (int u = blockIdx.x; u < 384 * 16; u += G) conv_unit(p, lds, u, u + G, tid, pre, wpre); }
    const int gw = blockIdx.x * 8 + wave, NGW = G * 8;
    bf16* QK = (bf16*)(p.ws + WS_QK); const float* qw = p.in[4]; const float* kw = p.in[5];
    for (int row0 = gw; row0 < M; row0 += 4 * NGW) {
        bf16x8 vv[4][2];
#pragma unroll
        for (int r = 0; r < 4; ++r)
#pragma unroll
            for (int pass = 0; pass < 2; ++pass) { const int row = row0 + r * NGW; if (row < M) vv[r][pass] = *(const bf16x8*)(QK + (size_t)row * 1024 + pass * 512 + lane * 8); }
#pragma unroll
        for (int r = 0; r < 4; ++r)
#pragma unroll
            for (int pass = 0; pass < 2; ++pass) { const int row = row0 + r * NGW; if (row >= M) continue;
                float f[8]; float ss = 0.f;
#pragma unroll
                for (int j = 0; j < 8; ++j) { f[j] = bf2f((unsigned short)vv[r][pass][j]); ss += f[j] * f[j]; }
                ss += __shfl_xor(ss, 1); ss += __shfl_xor(ss, 2); ss += __shfl_xor(ss, 4);
                const float rstd = rsqrtf(ss * (1.f / 64.f) + EPS) * (pass == 0 ? 0.125f : 1.f);
                const float* w = (pass ? kw : qw) + (lane & 7) * 8;
#pragma unroll
                for (int j = 0; j < 8; ++j) f[j] = f[j] * rstd * w[j];
                *(bf16x8*)(QK + (size_t)row * 1024 + pass * 512 + lane * 8) = pack8(f); }
    }
    const bf16* VZ = (const bf16*)(p.ws + WS_VZ); bf16* VT = (bf16*)((unsigned char*)p.out + DO_VT);
    unsigned short* scr = (unsigned short*)(lds + 65536 + wave * 8448);
    for (int it = gw; it < 768 * 8; it += NGW) { const int R = it >> 3, h = it & 7;
        const bf16* src = VZ + (size_t)(R * 64 + lane) * 1024 + h * 64;
#pragma unroll
        for (int seg = 0; seg < 8; ++seg) { const bf16x8 v = *(const bf16x8*)(src + seg * 8);
#pragma unroll
            for (int j = 0; j < 8; ++j) scr[lane * 66 + seg * 8 + j] = (unsigned short)v[j]; }
        LDS_WAIT();
#pragma unroll
        for (int seg = 0; seg < 8; ++seg) { u32x4 o;
            o.x = (unsigned)scr[(seg * 8 + 0) * 66 + lane] | ((unsigned)scr[(seg * 8 + 1) * 66 + lane] << 16);
            o.y = (unsigned)scr[(seg * 8 + 2) * 66 + lane] | ((unsigned)scr[(seg * 8 + 3) * 66 + lane] << 16);
            o.z = (unsigned)scr[(seg * 8 + 4) * 66 + lane] | ((unsigned)scr[(seg * 8 + 5) * 66 + lane] << 16);
            o.w = (unsigned)scr[(seg * 8 + 6) * 66 + lane] | ((unsigned)scr[(seg * 8 + 7) * 66 + lane] << 16);
            *(u32x4*)(VT + ((size_t)it * 64 + lane) * 64 + seg * 8) = o; }
        LDS_WAIT();
    }
}
__device__ __forceinline__ void attn_unit(const Params& p, const float* rpbs, int R, int h, int lane) {
    const bf16* QK = (const bf16*)(p.ws + WS_QK); const bf16* VT = (const bf16*)((const unsigned char*)p.out + DO_VT); bf16* MIX = (bf16*)(p.ws + WS_MIX);
    int r, rows; if (R < 256) { r = R & 127; rows = 128; } else { r = (R - 256) & 31; rows = 32; }
    const int Rb = R - r;
    int r0 = r - 4; r0 = r0 < 0 ? 0 : r0; r0 = r0 > rows - 8 ? rows - 8 : r0;
    const int fr = lane & 15, quad = lane >> 4;
    for (int qb = 0; qb < 4; ++qb) {
        const int kc0 = (qb == 0) ? 0 : (qb == 1 ? 8 : (qb == 2 ? 24 : 32));
        const int qc = qb * 16 + fr;
        const bf16* qp = QK + (size_t)(R * 64 + qc) * 1024 + h * 64 + quad * 8;
        bf16x8 qf0 = *(const bf16x8*)qp, qf1 = *(const bf16x8*)(qp + 32); mfma_operand_pad(qf0); mfma_operand_pad(qf1);
        f32x4 st[8][2];
#pragma unroll
        for (int i = 0; i < 8; ++i)
#pragma unroll
            for (int t = 0; t < 2; ++t) { const int kcm = kc0 + (fr >> 2) * 8 + 4 * t + (fr & 3);
                const bf16* kp = QK + (size_t)((Rb + r0 + i) * 64 + kcm) * 1024 + 512 + h * 64 + quad * 8;
                bf16x8 k0 = *(const bf16x8*)kp, k1 = *(const bf16x8*)(kp + 32); mfma_operand_pad(k0); mfma_operand_pad(k1);
                f32x4 a = {0.f, 0.f, 0.f, 0.f}; a = mfma16(k0, qf0, a); a = mfma16(k1, qf1, a); st[i][t] = a; }
        int c0q = qc - 8; c0q = c0q < 0 ? 0 : c0q; c0q = c0q > 48 ? 48 : c0q;
        float mx = -1e30f;
#pragma unroll
        for (int i = 0; i < 8; ++i)
#pragma unroll
            for (int t = 0; t < 2; ++t)
#pragma unroll
                for (int e = 0; e < 4; ++e) { const int kc = kc0 + quad * 8 + 4 * t + e; const bool valid = (kc >= c0q) && (kc < c0q + 16);
                    int dc = kc - qc + 15; dc = dc < 0 ? 0 : dc; dc = dc > 30 ? 30 : dc;
                    const float bv = rpbs[(h * 15 + (r0 + i - r + 7)) * 31 + dc];
                    float s = st[i][t][e] + bv; s = valid ? s : -1e30f; st[i][t][e] = s; mx = fmaxf(mx, s); }
        mx = fmaxf(mx, __shfl_xor(mx, 16)); mx = fmaxf(mx, __shfl_xor(mx, 32));
        float sum = 0.f;
#pragma unroll
        for (int i = 0; i < 8; ++i)
#pragma unroll
            for (int t = 0; t < 2; ++t)
#pragma unroll
                for (int e = 0; e < 4; ++e) { const float pe = __expf(st[i][t][e] - mx); st[i][t][e] = pe; sum += pe; }
        sum += __shfl_xor(sum, 16); sum += __shfl_xor(sum, 32);
        const float inv = 1.f / sum;
        f32x4 o[4];
#pragma unroll
        for (int dt = 0; dt < 4; ++dt) o[dt] = (f32x4){0.f, 0.f, 0.f, 0.f};
#pragma unroll
        for (int i = 0; i < 8; ++i) {
            float pv[8];
#pragma unroll
            for (int e = 0; e < 4; ++e) { pv[e] = st[i][0][e] * inv; pv[4 + e] = st[i][1][e] * inv; }
            bf16x8 pf = pack8(pv); mfma_operand_pad(pf);
#pragma unroll
            for (int dt = 0; dt < 4; ++dt) { const bf16* vp = VT + ((size_t)((Rb + r0 + i) * 8 + h) * 64 + dt * 16 + fr) * 64 + kc0 + quad * 8;
                bf16x8 vf = *(const bf16x8*)vp; mfma_operand_pad(vf); o[dt] = mfma16(pf, vf, o[dt]); }
        }
#pragma unroll
        for (int dt = 0; dt < 4; ++dt)
#pragma unroll
            for (int e = 0; e < 4; ++e) MIX[(size_t)(R * 64 + qb * 16 + quad * 4 + e) * 1024 + h * 64 + dt * 16 + fr] = f2bf(o[dt][e]);
    }
}

__device__ __forceinline__ void s1_unit(const Params& p, float* wts, int u, int lane, int wave) {
    const int c = u >> 3, h = u & 7, g = h >> 2, t0 = c * 128;
    const float* DT = (const float*)(p.ws + WS_DT); float* CDEC = (float*)(p.ws + WS_CDEC);
    if (wave < 2) { const int dir = wave;
        const float A = -__expf(dir ? p.in[12][h] : p.in[11][h]);
        const float d0 = DT[(size_t)(t0 + 2 * lane) * 16 + dir * 8 + h], d1 = DT[(size_t)(t0 + 2 * lane + 1) * 16 + dir * 8 + h];
        const float a0 = d0 * A, a1 = d1 * A; float p0, p1, tot; wave_scan2(a0, a1, lane, p0, p1, tot);
        float w0, w1;
        if (dir == 0) { w0 = __expf(tot - p0) * d0; w1 = __expf(tot - p1) * d1; }
        else { w0 = __expf(p0 - a0) * d0; w1 = __expf(p1 - a1) * d1; }
        wts[dir * 128 + 2 * lane] = w0; wts[dir * 128 + 2 * lane + 1] = w1;
        if (lane == 0) CDEC[((dir * 384 + c) * 8 + h) * 32] = __expf(tot);
    }
    PG8_LAS unsigned char* xtl = (PG8_LAS unsigned char*)(wts + 4096) + 2 * 64 * 136 * 2 + 2048;
    { const bf16* xsrc = (const bf16*)((const unsigned char*)p.out + DO_XT) + (size_t)(c * 8 + h) * 8192;
#pragma unroll
        for (int k = 0; k < 2; ++k) { const int q = wave * 2 + k, row = q * 4 + (lane >> 4);
            __builtin_amdgcn_global_load_lds((const unsigned*)(xsrc + row * 128 + (((lane & 15) ^ (row & 15)) * 8)), (PG8_LAS unsigned*)(xtl + q * 1024), 16, 0, 0); }
        asm volatile("s_waitcnt vmcnt(0)" ::: "memory"); }
    __syncthreads();
    const int fr = lane & 15, quad = lane >> 4;
    const bf16* XT = (const bf16*)((const unsigned char*)p.out + DO_XT); const bf16* BT = (const bf16*)((const unsigned char*)p.out + DO_BT);
    bf16* STATE = (bf16*)(p.ws + WS_XN);
    f32x4 acc[2][4];
#pragma unroll
    for (int d = 0; d < 2; ++d)
#pragma unroll
        for (int pt = 0; pt < 4; ++pt) acc[d][pt] = (f32x4){0.f, 0.f, 0.f, 0.f};
#pragma unroll
    for (int ks = 0; ks < 4; ++ks) {
        bf16x8 bfr = *(const bf16x8*)(BT + ((size_t)(c * 2 + g) * 128 + wave * 16 + fr) * 128 + ks * 32 + quad * 8); mfma_operand_pad(bfr);
        const f32x4 wf0 = *(const f32x4*)(wts + ks * 32 + quad * 8), wf1 = *(const f32x4*)(wts + ks * 32 + quad * 8 + 4);
        const f32x4 wb0 = *(const f32x4*)(wts + 128 + ks * 32 + quad * 8), wb1 = *(const f32x4*)(wts + 128 + ks * 32 + quad * 8 + 4);
#pragma unroll
        for (int pt = 0; pt < 4; ++pt) {
            const bf16x8 xf = *(const PG8_LAS bf16x8*)(xtl + (pt * 16 + fr) * 256 + (((ks * 4 + quad) ^ fr) * 16));
            float xv[8], sf[8], sb[8];
#pragma unroll
            for (int j = 0; j < 8; ++j) xv[j] = bf2f((unsigned short)xf[j]);
#pragma unroll
            for (int j = 0; j < 4; ++j) { sf[j] = xv[j] * wf0[j]; sf[4 + j] = xv[4 + j] * wf1[j]; sb[j] = xv[j] * wb0[j]; sb[4 + j] = xv[4 + j] * wb1[j]; }
            bf16x8 af = pack8(sf), ab = pack8(sb); mfma_operand_pad(af); mfma_operand_pad(ab);
            acc[0][pt] = mfma16(af, bfr, acc[0][pt]);
            acc[1][pt] = mfma16(ab, bfr, acc[1][pt]);
        }
    }
    unsigned short* stg = (unsigned short*)(wts + 4096);
#pragma unroll
    for (int d = 0; d < 2; ++d)
#pragma unroll
        for (int pt = 0; pt < 4; ++pt)
#pragma unroll
            for (int e = 0; e < 4; ++e) stg[(d * 64 + pt * 16 + quad * 4 + e) * 136 + wave * 16 + fr] = f2bf(acc[d][pt][e]);
    __syncthreads();
    { const int tid = wave * 64 + lane;
#pragma unroll
        for (int i = 0; i < 4; ++i) { const int piece = tid + 512 * i, row = piece >> 4, seg = piece & 15, d = row >> 6, pr = row & 63;
            const u32x4 v = *(const u32x4*)(stg + row * 136 + seg * 8);
            *(u32x4*)(STATE + ((((size_t)d * 384 + c) * 8 + h) * 64 + pr) * 128 + seg * 8) = v; } }
    __syncthreads();
}

__device__ __forceinline__ void phase_scan(const Params& p, int tid, int G) {
    bf16* STATE = (bf16*)(p.ws + WS_XN); const float* CDEC = (const float*)(p.ws + WS_CDEC);
    for (int gt = blockIdx.x * 512 + tid; gt < 131072; gt += G * 512) {
        if (gt < 65536) {
            const int e4 = gt & 2047, h = (gt >> 11) & 7, sd = gt >> 14, sq = sd & 1, dir = sd >> 1, c0 = sq * 64;
            const int cstep = dir ? -1 : 1, cfirst = dir ? c0 + 63 : c0;
            u32x2* base = (u32x2*)(STATE + ((size_t)dir * 384 * 8 + h) * 8192 + e4 * 4);
            const float* dbase = CDEC + (dir * 384 * 8 + h) * 32;
            float hs[4] = {0.f, 0.f, 0.f, 0.f};
            u32x2 qv[8]; float qd[8];
#pragma unroll
            for (int j = 0; j < 8; ++j) { const int c = cfirst + cstep * j; qv[j] = base[(size_t)c * 16384]; qd[j] = dbase[c * 256]; }
#pragma unroll 1
            for (int s0 = 0; s0 < 64; s0 += 8) {
#pragma unroll
                for (int j = 0; j < 8; ++j) { const int c = cfirst + cstep * (s0 + j);
                    const u32x2 v = qv[j]; const float dec = qd[j];
                    if (s0 + 8 < 64) { const int cn = c + cstep * 8; qv[j] = base[(size_t)cn * 16384]; qd[j] = dbase[cn * 256]; }
                    u32x2 o; o.x = pk2(hs[0], hs[1]); o.y = pk2(hs[2], hs[3]); base[(size_t)c * 16384] = o;
                    hs[0] = hs[0] * dec + bf2f(v.x & 0xffffu); hs[1] = hs[1] * dec + bf2f(v.x >> 16); hs[2] = hs[2] * dec + bf2f(v.y & 0xffffu); hs[3] = hs[3] * dec + bf2f(v.y >> 16); }
            }
        } else {
            const int k = gt - 65536;
            float hs[4][8];
#pragma unroll
            for (int j = 0; j < 4; ++j)
#pragma unroll
                for (int i = 0; i < 8; ++i) hs[j][i] = 0.f;
            bf16* cb[4]; const float* db[4]; int cstep[4];
#pragma unroll
            for (int j = 0; j < 4; ++j) { const int it = k + 65536 * j, e8 = it & 1023, h = (it >> 10) & 7, sd = it >> 13, dir = sd >> 4, c0 = 128 + (sd & 15) * 16;
                const int cf = dir ? c0 + 15 : c0; cstep[j] = dir ? -1 : 1;
                cb[j] = STATE + (((size_t)dir * 384 + cf) * 8 + h) * 8192 + e8 * 8; db[j] = CDEC + ((dir * 384 + cf) * 8 + h) * 32; }
            bf16x8 qv[2][4]; float qd[2][4];
#pragma unroll
            for (int d = 0; d < 2; ++d)
#pragma unroll
                for (int j = 0; j < 4; ++j) { qv[d][j] = *(const bf16x8*)(cb[j] + (ptrdiff_t)cstep[j] * d * 65536); qd[d][j] = db[j][cstep[j] * d * 256]; }
#pragma unroll 1
            for (int s0 = 0; s0 < 16; s0 += 2) {
#pragma unroll
                for (int d = 0; d < 2; ++d)
#pragma unroll
                    for (int j = 0; j < 4; ++j) { const int st = s0 + d;
                        const bf16x8 v = qv[d][j]; const float dec = qd[d][j];
                        if (s0 + 2 < 16) { qv[d][j] = *(const bf16x8*)(cb[j] + (ptrdiff_t)cstep[j] * (st + 2) * 65536); qd[d][j] = db[j][cstep[j] * (st + 2) * 256]; }
                        *(bf16x8*)(cb[j] + (ptrdiff_t)cstep[j] * st * 65536) = pack8(hs[j]);
#pragma unroll
                        for (int i = 0; i < 8; ++i) hs[j][i] = hs[j][i] * dec + bf2f((unsigned short)v[i]); }
            }
        }
    }
}

__device__ __forceinline__ void s3_unit(const Params& p, unsigned char* lds, int u, int lane, int wave) {
    const int c = u >> 1, g = u & 1, t0 = c * 128;
    float* acsf = (float*)lds; float* rcsb = acsf + 512; float* dtf = acsf + 1024; float* dtb = acsf + 1536;
    const float* DT = (const float*)(p.ws + WS_DT);
    { const int hl = wave & 3, dir = wave >> 2, h = g * 4 + hl;
        const float A = -__expf(dir ? p.in[12][h] : p.in[11][h]);
        const float d0 = DT[(size_t)(t0 + 2 * lane) * 16 + dir * 8 + h], d1 = DT[(size_t)(t0 + 2 * lane + 1) * 16 + dir * 8 + h];
        const float a0 = d0 * A, a1 = d1 * A; float p0, p1, tot; wave_scan2(a0, a1, lane, p0, p1, tot);
        if (dir == 0) { acsf[hl * 128 + 2 * lane] = p0; acsf[hl * 128 + 2 * lane + 1] = p1; dtf[hl * 128 + 2 * lane] = d0; dtf[hl * 128 + 2 * lane + 1] = d1; }
        else { rcsb[hl * 128 + 2 * lane] = tot - p0 + a0; rcsb[hl * 128 + 2 * lane + 1] = tot - p1 + a1; dtb[hl * 128 + 2 * lane] = d0; dtb[hl * 128 + 2 * lane + 1] = d1; }
    }
    __syncthreads();
    const int fr = lane & 15, quad = lane >> 4, lrow = 16 * wave + fr, l4 = 16 * wave + quad * 4;
    const unsigned char* dout = (const unsigned char*)p.out;
    const bf16* XT = (const bf16*)(dout + DO_XT); const bf16* BROW = (const bf16*)(dout + DO_BROW); const bf16* CROW = (const bf16*)(dout + DO_CROW);
    const bf16* STATE = (const bf16*)(p.ws + WS_XN); const bf16* VZ = (const bf16*)(p.ws + WS_VZ); bf16* MIX = (bf16*)(p.ws + WS_MIX);
    bf16x8 cf[4];
#pragma unroll
    for (int ks = 0; ks < 4; ++ks) { cf[ks] = *(const bf16x8*)(CROW + (size_t)(t0 + lrow) * 256 + g * 128 + ks * 32 + quad * 8); mfma_operand_pad(cf[ks]); }
    PG8_LAS unsigned char* tlb = (PG8_LAS unsigned char*)lds + 74240;
#pragma unroll
    for (int k = 0; k < 4; ++k) { const int q = wave * 4 + k, row = q * 4 + (lane >> 4);
        __builtin_amdgcn_global_load_lds((const unsigned*)(BROW + (size_t)(t0 + row) * 256 + g * 128 + (((lane & 15) ^ (row & 15)) * 8)), (PG8_LAS unsigned*)(tlb + q * 1024), 16, 0, 0); }
    asm volatile("s_waitcnt vmcnt(0)" ::: "memory");
    __syncthreads();
    f32x4 cb[4][2];
#pragma unroll
    for (int sp = 0; sp < 4; ++sp)
#pragma unroll
        for (int t = 0; t < 2; ++t) { const int srow = sp * 32 + (fr >> 2) * 8 + 4 * t + (fr & 3);
            f32x4 a = {0.f, 0.f, 0.f, 0.f};
#pragma unroll
            for (int ks = 0; ks < 4; ++ks) a = mfma16(*(const PG8_LAS bf16x8*)(tlb + srow * 256 + (((ks * 4 + quad) ^ (srow & 15)) * 16)), cf[ks], a);
            cb[sp][t] = a; }
    float ssq[4] = {0.f, 0.f, 0.f, 0.f};
    unsigned short* gsm = (unsigned short*)(lds + 8192 + wave * 8192);
    float* rsm = (float*)(lds + 8192 + 8 * 8192) + wave * 16;
    PG8_LAS unsigned char* tl = (PG8_LAS unsigned char*)lds + 74240;
    const int dj = lane >> 4;
    const int dcp = lane & 15;
    const float* nw = p.in[14];
#pragma unroll 1
    for (int hl = 0; hl < 4; ++hl) { const int h = g * 4 + hl;
        const bf16* xth = XT + (size_t)(c * 8 + h) * 8192;
        const bf16* stf = STATE + ((size_t)c * 8 + h) * 8192; const bf16* stb = stf + (size_t)384 * 8 * 8192;
        __syncthreads();
#pragma unroll
        for (int k = 0; k < 2; ++k) { const int row = (wave * 2 + k) * 4 + dj; const int so = row * 128 + ((dcp ^ (row & 15)) * 8);
            __builtin_amdgcn_global_load_lds((const unsigned*)(xth + so), (PG8_LAS unsigned*)(tl + (wave * 2 + k) * 1024), 16, 0, 0);
            __builtin_amdgcn_global_load_lds((const unsigned*)(stf + so), (PG8_LAS unsigned*)(tl + 16384 + (wave * 2 + k) * 1024), 16, 0, 0);
            __builtin_amdgcn_global_load_lds((const unsigned*)(stb + so), (PG8_LAS unsigned*)(tl + 32768 + (wave * 2 + k) * 1024), 16, 0, 0); }
        asm volatile("s_waitcnt vmcnt(0)" ::: "memory");
        __syncthreads();
        const float af_l = acsf[hl * 128 + lrow], rb_l = rcsb[hl * 128 + lrow];
        f32x4 Y[4];
        {
            f32x4 Yf[4], Yb[4];
#pragma unroll
            for (int pt = 0; pt < 4; ++pt) { Yf[pt] = (f32x4){0.f, 0.f, 0.f, 0.f}; Yb[pt] = Yf[pt]; }
#pragma unroll
            for (int ks = 0; ks < 4; ++ks) {
#pragma unroll
                for (int pt = 0; pt < 4; ++pt) {
                    const int lo = (pt * 16 + fr) * 256 + (((ks * 4 + quad) ^ fr) * 16);
                    Yf[pt] = mfma16(cf[ks], *(const PG8_LAS bf16x8*)(tl + 16384 + lo), Yf[pt]);
                    Yb[pt] = mfma16(cf[ks], *(const PG8_LAS bf16x8*)(tl + 32768 + lo), Yb[pt]);
                }
            }
            const f32x4 ea = *(const f32x4*)(acsf + hl * 128 + l4), eb = *(const f32x4*)(rcsb + hl * 128 + l4);
            f32x4 xa, xb;
#pragma unroll
            for (int e = 0; e < 4; ++e) { xa[e] = __expf(ea[e]); xb[e] = __expf(eb[e]); }
#pragma unroll
            for (int pt = 0; pt < 4; ++pt) Y[pt] = xa * Yf[pt] + xb * Yb[pt];
        }
#pragma unroll
        for (int sp = 0; sp < 4; ++sp) { const int s0 = sp * 32 + quad * 8;
            float mv[8];
#pragma unroll
            for (int t = 0; t < 2; ++t) {
                const f32x4 afs = *(const f32x4*)(acsf + hl * 128 + s0 + 4 * t), rbs = *(const f32x4*)(rcsb + hl * 128 + s0 + 4 * t);
                const f32x4 dfs = *(const f32x4*)(dtf + hl * 128 + s0 + 4 * t), dbs = *(const f32x4*)(dtb + hl * 128 + s0 + 4 * t);
#pragma unroll
                for (int e = 0; e < 4; ++e) { const int s = s0 + 4 * t + e;
                    const float ef = __expf(fminf(af_l - afs[e], 0.f)) * dfs[e], eb2 = __expf(fminf(rb_l - rbs[e], 0.f)) * dbs[e];
                    const float vf = (s <= lrow) ? ef : 0.f;
                    const float vb = (s >= lrow) ? eb2 : 0.f;
                    mv[4 * t + e] = cb[sp][t][e] * (vf + vb); }
            }
            bf16x8 mf = pack8(mv); mfma_operand_pad(mf);
#pragma unroll
            for (int pt = 0; pt < 4; ++pt) Y[pt] = mfma16(mf, *(const PG8_LAS bf16x8*)(tl + (pt * 16 + fr) * 256 + (((sp * 4 + quad) ^ fr) * 16)), Y[pt]);
        }
        const float Dk = p.in[13][h];
#pragma unroll
        for (int pt = 0; pt < 4; ++pt) { const int pc = pt * 16 + fr;
            const u32x2 xw = *(const u32x2*)(xth + (size_t)pc * 128 + l4);
            const float xv[4] = {bf2f(xw.x & 0xffffu), bf2f(xw.x >> 16), bf2f(xw.y & 0xffffu), bf2f(xw.y >> 16)};
            const float wn = nw[h * 64 + pc];
#pragma unroll
            for (int e = 0; e < 4; ++e) { const size_t off = (size_t)(t0 + l4 + e) * 1024 + 512 + h * 64 + pc;
                const float zv = bf2f(VZ[off]);
                const float y = Y[pt][e] + Dk * xv[e];
                const float gg = y * silu(zv); ssq[e] += gg * gg;
                gsm[(quad * 4 + e) * 256 + hl * 64 + pc] = f2bf(gg * wn); }
        }
    }
#pragma unroll
    for (int e = 0; e < 4; ++e) { float ss = ssq[e];
        ss += __shfl_xor(ss, 1); ss += __shfl_xor(ss, 2); ss += __shfl_xor(ss, 4); ss += __shfl_xor(ss, 8);
        if (fr == 0) rsm[quad * 4 + e] = rsqrtf(ss * (1.f / 256.f) + EPS); }
    LDS_WAIT();
    { const int r = lane >> 2; const float rs = rsm[r];
        bf16* mp = MIX + (size_t)(t0 + 16 * wave + r) * 1024 + 512 + g * 256 + (lane & 3) * 64;
        const unsigned short* gp = gsm + r * 256 + (lane & 3) * 64;
#pragma unroll
        for (int it = 0; it < 8; ++it) { const u32x4 w = *(const u32x4*)(gp + it * 8);
            u32x4 o; o.x = pk2(bf2f(w.x & 0xffffu) * rs, bf2f(w.x >> 16) * rs); o.y = pk2(bf2f(w.y & 0xffffu) * rs, bf2f(w.y >> 16) * rs);
            o.z = pk2(bf2f(w.z & 0xffffu) * rs, bf2f(w.z >> 16) * rs); o.w = pk2(bf2f(w.w & 0xffffu) * rs, bf2f(w.w >> 16) * rs);
            *(u32x4*)(mp + it * 8) = o; }
    }
    __syncthreads();
}
using pg8::Unit;
struct EpiProj {
    static constexpr bool PERM = true, AFTER_DRAIN = false;
    bf16* O;
    __device__ __forceinline__ void operator()(const f32x4 (&acc)[2][2][4][2], const Unit& u, int wr, int wc, int fr, int fq) const {
        const int row0 = u.pm * 256 + wr * 64 + fr; const int colt = u.pn * 256; const int piece = colt >> 10;
        bf16* base = O + (size_t)piece * ((size_t)M * 1024) + (colt & 1023) + wc * 32 + 8 * fq;
#pragma unroll
        for (int ai = 0; ai < 2; ++ai)
#pragma unroll
            for (int m = 0; m < 4; ++m) { bf16* rowp = base + (size_t)(row0 + ai * 128 + m * 16) * 1024;
#pragma unroll
                for (int bj = 0; bj < 2; ++bj) { const f32x4 v0 = acc[ai][bj][m][0], v1 = acc[ai][bj][m][1];
                    u32x4 w; w.x = pk2(v0[0], v0[1]); w.y = pk2(v0[2], v0[3]); w.z = pk2(v1[0], v1[1]); w.w = pk2(v1[2], v1[3]);
                    *(u32x4*)(rowp + bj * 128) = w; } }
    }
};
struct EpiOut {
    static constexpr bool PERM = true, AFTER_DRAIN = false;
    const float* xp; const float* xs; float* out; bf16* xb; float* rowss;
    __device__ __forceinline__ void operator()(const f32x4 (&acc)[2][2][4][2], const Unit& u, int wr, int wc, int fr, int fq) const {
        const int row0 = u.pm * 256 + wr * 64 + fr; const int col0 = u.pn * 256 + wc * 32 + 8 * fq;
#pragma unroll
        for (int ai = 0; ai < 2; ++ai)
#pragma unroll
            for (int m = 0; m < 4; ++m) { const int row = row0 + ai * 128 + m * 16;
                const float* xr = (row < MP ? xp + (size_t)row * 1024 : xs + (size_t)(row - MP) * 1024) + col0;
                float ss = 0.f;
#pragma unroll
                for (int bj = 0; bj < 2; ++bj) {
                    const f32x4 v0 = acc[ai][bj][m][0] + *(const f32x4*)(xr + bj * 128), v1 = acc[ai][bj][m][1] + *(const f32x4*)(xr + bj * 128 + 4);
                    float* op = out + (size_t)row * 1024 + col0 + bj * 128; *(f32x4*)op = v0; *(f32x4*)(op + 4) = v1;
                    u32x4 w; w.x = pk2(v0[0], v0[1]); w.y = pk2(v0[2], v0[3]); w.z = pk2(v1[0], v1[1]); w.w = pk2(v1[2], v1[3]);
                    *(u32x4*)(xb + (size_t)row * 1024 + col0 + bj * 128) = w;
                    ss += (v0[0] * v0[0] + v0[1] * v0[1]) + (v0[2] * v0[2] + v0[3] * v0[3]) + (v1[0] * v1[0] + v1[1] * v1[1]) + (v1[2] * v1[2] + v1[3] * v1[3]); }
                ss += __shfl_xor(ss, 16); ss += __shfl_xor(ss, 32);
                if (fq == 0) rowss[((size_t)u.pn * M + row) * 4 + wc] = ss; }
    }
};
struct EpiGU {
    static constexpr bool PERM = true, AFTER_DRAIN = false;
    bf16* hid; const float* rowss;
    __device__ __forceinline__ void operator()(const f32x4 (&acc)[2][2][4][2], const Unit& u, int wr, int wc, int fr, int fq) const {
        const int row0 = u.pm * 256 + wr * 64 + fr; const int col0 = u.pn * 128 + wc * 32 + 8 * fq;
#pragma unroll
        for (int ai = 0; ai < 2; ++ai)
#pragma unroll
            for (int m = 0; m < 4; ++m) { const int row = row0 + ai * 128 + m * 16;
                const f32x4* pp = (const f32x4*)(rowss + (size_t)row * 4); const f32x4 q0 = pp[0], q1 = pp[M], q2 = pp[2 * M], q3 = pp[3 * M];
                const float rsum = ((q0[0] + q0[1]) + (q0[2] + q0[3])) + ((q1[0] + q1[1]) + (q1[2] + q1[3])) + ((q2[0] + q2[1]) + (q2[2] + q2[3])) + ((q3[0] + q3[1]) + (q3[2] + q3[3]));
                const float rstd = rsqrtf(rsum * (1.f / 1024.f) + EPS);
                float hv[8];
#pragma unroll
                for (int n = 0; n < 2; ++n)
#pragma unroll
                    for (int e = 0; e < 4; ++e) { const float gt = acc[ai][0][m][n][e] * rstd, up = acc[ai][1][m][n][e] * rstd; hv[4 * n + e] = silu(gt) * up; }
                *(bf16x8*)(hid + (size_t)row * 2816 + col0) = pack8(hv); }
    }
};
struct EpiDown {
    static constexpr bool PERM = true, AFTER_DRAIN = false;
    float* out;
    __device__ __forceinline__ void operator()(const f32x4 (&acc)[2][2][4][2], const Unit& u, int wr, int wc, int fr, int fq) const {
        const int row0 = u.pm * 256 + wr * 64 + fr; const int col0 = u.pn * 256 + wc * 32 + 8 * fq;
#pragma unroll
        for (int ai = 0; ai < 2; ++ai)
#pragma unroll
            for (int m = 0; m < 4; ++m) { float* op = out + (size_t)(row0 + ai * 128 + m * 16) * 1024 + col0;
#pragma unroll
                for (int bj = 0; bj < 2; ++bj) { const f32x4 a0 = *(const f32x4*)(op + bj * 128), a1 = *(const f32x4*)(op + bj * 128 + 4);
                    *(f32x4*)(op + bj * 128) = a0 + acc[ai][bj][m][0]; *(f32x4*)(op + bj * 128 + 4) = a1 + acc[ai][bj][m][1]; } }
    }
};

#define LAS __attribute__((address_space(3)))
#define XB_TMO      128
#define XB_XCNT(j)  (256  + 64 * (j))
#define XB_XSUB(j)  (1280 + 64 * (j))
#define XB_XGEN(j)  (2304 + 64 * (j))
#define XB_TOP      3328
#define XB_TOPGEN   3392
#define XCD_BAR_WORDS 3456
#define XB_SPIN_CAP (1u << 18)

__device__ __forceinline__ unsigned xb_ld(unsigned* p)              { return __hip_atomic_load(p, __ATOMIC_RELAXED, __HIP_MEMORY_SCOPE_AGENT); }
__device__ __forceinline__ unsigned xb_add(unsigned* p, unsigned v) { return __hip_atomic_fetch_add(p, v, __ATOMIC_RELAXED, __HIP_MEMORY_SCOPE_AGENT); }
__device__ __forceinline__ unsigned xb_xcc_id() { return (unsigned)__builtin_amdgcn_s_getreg((3 << 11) | 20) & 0xFu; }
#define XB_SPIN(cond, bar) do { unsigned _sp = 0; while (cond) { __builtin_amdgcn_s_sleep(1); \
    if ((++_sp & 255u) == 0u) { if (xb_ld(&(bar)[XB_TMO])) break; if (_sp > XB_SPIN_CAP) { atomicAdd(&(bar)[XB_TMO], 1u); break; } } } } while (0)

struct XcdBarrier {
    unsigned* bar; unsigned x;
    volatile LAS unsigned* st;
};

__device__ __forceinline__ XcdBarrier xcd_barrier_post(unsigned* bar, volatile LAS unsigned* st) {
    XcdBarrier b; b.bar = bar; b.x = xb_xcc_id(); b.st = st;
    if (threadIdx.x == 0) (void)xb_add(&bar[XB_XCNT(b.x)], 1u);
    return b;
}
__device__ __forceinline__ void xcd_barrier_complete(unsigned* bar, unsigned x, unsigned& nloc, unsigned& nx) {
    const unsigned G = gridDim.x * gridDim.y * gridDim.z;
    unsigned sum, cnt, mine, sp = 0u;
    for (;;) {
        sum = 0u; cnt = 0u; mine = 0u;
#pragma unroll
        for (unsigned j = 0; j < 16; ++j) { const unsigned c = xb_ld(&bar[XB_XCNT(j)]); sum += c; cnt += (c > 0u) ? 1u : 0u; mine = (j == x) ? c : mine; }
        if (sum == G) break;
        __builtin_amdgcn_s_sleep(1);
        if ((++sp & 255u) == 0u) { if (xb_ld(&bar[XB_TMO])) break; if (sp > XB_SPIN_CAP) { atomicAdd(&bar[XB_TMO], 1u); break; } }
    }
    nloc = mine > 0u ? mine : 1u; nx = cnt > 0u ? cnt : 1u;
}

__device__ __forceinline__ void xcd_barrier(const XcdBarrier& b) {
    asm volatile("s_waitcnt vmcnt(0)" ::: "memory");
    __syncthreads();
    if (threadIdx.x == 0) {
        unsigned* bar = b.bar;
        __builtin_amdgcn_s_waitcnt(0);
        unsigned nloc = b.st[0], nx = b.st[1];
        if (nloc == 0u) { xcd_barrier_complete(bar, b.x, nloc, nx); b.st[0] = nloc; b.st[1] = nx; }
        const unsigned old = xb_add(&bar[XB_XSUB(b.x)], 1u);
        const unsigned gen = old / nloc;
        if (old + 1u == (gen + 1u) * nloc) {
            __builtin_amdgcn_fence(__ATOMIC_RELEASE, "agent");
            asm volatile("s_waitcnt vmcnt(0)" ::: "memory");
            const unsigned og = xb_add(&bar[XB_TOP], 1u);
            const unsigned tg = og / nx;
            if (og + 1u == (tg + 1u) * nx) xb_add(&bar[XB_TOPGEN], 1u);
            else XB_SPIN(xb_ld(&bar[XB_TOPGEN]) == tg, bar);
            __builtin_amdgcn_fence(__ATOMIC_ACQUIRE, "agent");
            xb_add(&bar[XB_XGEN(b.x)], 1u);
            asm volatile("s_waitcnt vmcnt(0)" ::: "memory");
        } else {
            XB_SPIN(xb_ld(&bar[XB_XGEN(b.x)]) == gen, bar);
            __builtin_amdgcn_fence(__ATOMIC_ACQUIRE, "agent");
            asm volatile("s_waitcnt vmcnt(0)" ::: "memory");
        }
    }
    __syncthreads();
}


__device__ __forceinline__ void gsync(cg::grid_group& grid) {
    asm volatile("s_waitcnt vmcnt(0) lgkmcnt(0)" ::: "memory");
    __syncthreads();
    grid.sync();
    __builtin_amdgcn_fence(__ATOMIC_ACQUIRE, "agent");
    asm volatile("s_waitcnt vmcnt(0)" ::: "memory");
    __syncthreads();
}
constexpr int LDS_BYTES = 147456;
__global__ void __launch_bounds__(512, 2) hymba_fwd(Params p) {
    extern __shared__ __attribute__((aligned(16))) unsigned char lds[];
    cg::grid_group grid = cg::this_grid();
    const int tid = threadIdx.x, lane = tid & 63, wave = __builtin_amdgcn_readfirstlane(tid >> 6), G = gridDim.x;
    PG8_LAS unsigned char* glds = (PG8_LAS unsigned char*)lds;
    volatile LAS unsigned* MISC = (volatile LAS unsigned*)((LAS unsigned char*)lds + (LDS_BYTES - 64));
    if (tid < 16) MISC[tid] = 0u;
    unsigned* barw = (unsigned*)(p.ws + WS_BAR);
    if (blockIdx.x == 0) for (int i = tid; i < XCD_BAR_WORDS; i += 512) __hip_atomic_store(barw + i, 0u, __ATOMIC_RELAXED, __HIP_MEMORY_SCOPE_AGENT);
    __syncthreads();

#ifndef SKIP_P0
    phase0(p, lds, tid, lane, wave, G);
#endif
    gsync(grid);
    const XcdBarrier xbar = xcd_barrier_post(barw, MISC + 8);
#ifndef SKIP_P1
    { pg8::Gemm g{(const bf16*)(p.ws + WS_XN), (const bf16*)(p.ws + WS_WIN), M, 3072, 1024}; pg8::StaticOrder S; S.init(M, 3072, G, (int)blockIdx.x);
      EpiProj E{(bf16*)(p.ws + WS_QK)};
      pg8::gemm_phase<EpiProj, pg8::StaticOrder, true, true>(glds, g, S, E); }
#endif
    xcd_barrier(xbar);
#ifndef SKIP_P2
    phase2(p, lds, tid, lane, wave, G);
#endif
    xcd_barrier(xbar);
    { float* rpbs = (float*)lds; float* wts = (float*)(lds + 16384);
      for (int i = tid; i < 8 * 15 * 31; i += 512) rpbs[i] = p.in[6][i];
      __syncthreads();
#ifndef SKIP_P3A
      const int vcu = (G % 8 == 0) ? (int)(blockIdx.x % 8) * (G / 8) + (int)(blockIdx.x / 8) : (int)blockIdx.x;
      for (int R = vcu; R < 768; R += G) attn_unit(p, rpbs, R, wave, lane);
#endif
#ifndef SKIP_P3B
      for (int u = vcu; u < 384 * 8; u += G) s1_unit(p, wts, u, lane, wave);
#endif
    }
    xcd_barrier(xbar);
#ifndef SKIP_P4
    phase_scan(p, tid, G);
#endif
    xcd_barrier(xbar);
#ifndef SKIP_P5
    for (int u = blockIdx.x; u < 768; u += G) s3_unit(p, lds, u, lane, wave);
#endif
    xcd_barrier(xbar);
#ifndef SKIP_P6
    { pg8::Gemm g{(const bf16*)(p.ws + WS_MIX), (const bf16*)(p.ws + WS_WOUT), M, 1024, 1024}; pg8::StaticOrder S; S.init(M, 1024, G, (int)blockIdx.x);
      EpiOut E{p.in[0], p.in[1], p.out, (bf16*)(p.ws + WS_XN), (float*)(p.ws + WS_PART)};
      pg8::gemm_phase<EpiOut, pg8::StaticOrder, true, true>(glds, g, S, E); }
#endif
    xcd_barrier(xbar);
#ifndef SKIP_P7
    { pg8::Gemm g{(const bf16*)(p.ws + WS_XN), (const bf16*)(p.ws + WS_WGU), M, 5632, 1024}; pg8::StaticOrder S; S.init(M, 5632, G, (int)blockIdx.x);
      EpiGU E{(bf16*)(p.ws + WS_HID), (const float*)(p.ws + WS_PART)};
      pg8::gemm_phase<EpiGU, pg8::StaticOrder, true, true>(glds, g, S, E); }
#endif
    xcd_barrier(xbar);
#ifndef SKIP_P8
    { pg8::Gemm g{(const bf16*)(p.ws + WS_HID), (const bf16*)(p.ws + WS_WDN), M, 1024, 2816}; pg8::StaticOrder S; S.init(M, 1024, G, (int)blockIdx.x);
      EpiDown E{p.out};
      pg8::gemm_phase<EpiDown, pg8::StaticOrder, true, true>(glds, g, S, E); }
#endif
}
}

extern "C" void kernel_launch(void* const* d_in, const int* in_sizes, int n_in, void* d_out, int out_size, void* d_ws, size_t ws_size, hipStream_t stream) {
    static int grid = 0;
    if (grid == 0) {
        if (n_in != 20 || out_size != hk::M * 1024 || ws_size < hk::WS_END) { fprintf(stderr, "kernel_launch: unexpected shapes (n_in %d out %d ws %zu)\n", n_in, out_size, ws_size); grid = -1; return; }
        int dev = 0, cus = 0, per_cu = 0;
        if (hipGetDevice(&dev) != hipSuccess || hipDeviceGetAttribute(&cus, hipDeviceAttributeMultiprocessorCount, dev) != hipSuccess) { grid = -1; return; }
        if (hipFuncSetAttribute((const void*)hk::hymba_fwd, hipFuncAttributeMaxDynamicSharedMemorySize, hk::LDS_BYTES) != hipSuccess) { fprintf(stderr, "kernel_launch: hipFuncSetAttribute failed\n"); grid = -1; return; }
        if (hipOccupancyMaxActiveBlocksPerMultiprocessor(&per_cu, (const void*)hk::hymba_fwd, 512, hk::LDS_BYTES) != hipSuccess || per_cu < 1) { fprintf(stderr, "kernel_launch: occupancy query says %d\n", per_cu); (void)hipGetLastError(); grid = -1; return; }
        grid = cus * 1;
    }
    if (grid < 0) return;
    hk::Params prm{};
    for (int i = 0; i < 20; ++i) prm.in[i] = (const float*)d_in[i];
    prm.out = (float*)d_out; prm.ws = (unsigned char*)d_ws;
    void* args[] = {&prm};
    hipError_t e = hipLaunchCooperativeKernel((const void*)hk::hymba_fwd, dim3(grid), dim3(512), args, hk::LDS_BYTES, stream);
    if (e != hipSuccess) fprintf(stderr, "cooperative launch failed: %s (grid %d)\n", hipGetErrorString(e), grid);
}
```

```cpp
#include <hip/hip_runtime.h>
#include <hip/hip_cooperative_groups.h>
#include <cstdio>
#include <cstdint>
namespace cg = cooperative_groups;
namespace pg8 {
#define PG8_LAS __attribute__((address_space(3)))
typedef unsigned short bf16_t;
typedef short bf16x8 __attribute__((ext_vector_type(8)));
typedef float f32x4 __attribute__((ext_vector_type(4)));
typedef unsigned u32x4 __attribute__((ext_vector_type(4)));
constexpr int BM = 256, BK = 64, HALF = 128, HTB = HALF * BK * 2  , STAGE_BYTES = 8 * HTB, NXCD = 8, WGM = 4;

__host__ __device__ __forceinline__ int lds_byte(int r, int c) { const int st = (r >> 4) * 2 + (c >> 5), rr = r & 15, cc = c & 31, ob = rr * 64 + cc * 2; return st * 1024 + (ob ^ (((ob >> 9) & 1) << 5)); }
__host__ __device__ __forceinline__ void stage_rc(int b, int& R, int& C) { const int st = b / 1024, sb = b % 1024, swz = sb ^ (((sb >> 9) & 1) << 5); R = (st >> 1) * 16 + swz / 64; C = (st & 1) * 32 + (swz % 64) / 2; }
__host__ __device__ __forceinline__ int perm32(int rho) { const int n = rho >> 4, i = rho & 15; return 8 * (i >> 2) + 4 * n + (i & 3); }

struct Unit { int pm, pn; };
struct Gemm { const bf16_t* A; const bf16_t* Bt; int M, N, K; };

struct StaticOrder {
    int nM, nN, nwg, G, c;
    __host__ __device__ void init(int M, int N, int G_, int c_) { nM = M / BM; nN = N / BM; nwg = nM * nN; G = G_; c = c_; }
    __host__ __device__ bool next(int i, Unit& u) const {
        const long L = (long)i * G + c; if (L >= nwg) return false;
        int wgid = (int)L; { const int q = nwg / NXCD, r = nwg % NXCD, xcd = wgid % NXCD, off = wgid / NXCD; wgid = (xcd < r ? xcd * (q + 1) : r * (q + 1) + (xcd - r) * q) + off; }
        const int nig = WGM * nN, gid = wgid / nig, fm = gid * WGM, gsz = (nM - fm) < WGM ? (nM - fm) : WGM;
        u.pm = fm + ((wgid % nig) % gsz); u.pn = (wgid % nig) / gsz; return true;
    }
    __device__ __forceinline__ void a_ready(const Unit&) const {}
    __device__ __forceinline__ void done(const Unit&) const {}
};

__device__ __forceinline__ unsigned cvt_pk_bf16(float lo, float hi) { unsigned r; asm volatile("v_cvt_pk_bf16_f32 %0, %1, %2" : "=v"(r) : "v"(lo), "v"(hi)); return r; }
template <class Epi, class Sched, bool ALIGN_EPI = false, bool SP2 = false>
__device__ __forceinline__ void gemm_phase(PG8_LAS unsigned char* lds, const Gemm g, const Sched& S, const Epi& E) {
    const int tid = threadIdx.x, wid = __builtin_amdgcn_readfirstlane(tid >> 6), lane = tid & 63, wr = wid >> 2, wc = wid & 3, fr = lane & 15, fq = lane >> 4;
    const int K = g.K, nt = K / BK;
    unsigned voffA[2], voffB[2];
#pragma unroll
    for (int i = 0; i < 2; ++i) { int R, C; stage_rc(tid * 16 + i * 8192, R, C); const int Rb = Epi::PERM ? ((R & ~31) + perm32(R & 31)) : R;
        voffA[i] = (unsigned)(R * K + C) * 2u; voffB[i] = (unsigned)(Rb * K + C) * 2u; }
    const size_t kstep = (size_t)(BK * 2);
    const size_t hstep = (size_t)HALF * K * 2;
    const size_t tstep = 2 * hstep;
    const unsigned ldsw = (unsigned)wid * 1024u;
    const int aoff = lds_byte(wr * 64 + fr, fq * 8), boff = lds_byte(wc * 32 + fr, fq * 8);
#define PG8_SA(b, h) (((b) * 2 + (h)) * HTB)
#define PG8_SB(b, h) ((4 + (b) * 2 + (h)) * HTB)
#define PG8_STAGE(bufoff, gbase, voff) do { _Pragma("unroll") for (int _i = 0; _i < 2; ++_i) \
        __builtin_amdgcn_global_load_lds((const unsigned*)((const char*)(gbase) + (voff)[_i]), (PG8_LAS unsigned*)(lds + (bufoff) + ldsw + _i * 8192), 16, 0, 0); } while (0)
#define PG8_LDA(dst, b, h) do { _Pragma("unroll") for (int m = 0; m < 4; ++m) _Pragma("unroll") for (int k = 0; k < 2; ++k) dst[m][k] = *(const PG8_LAS bf16x8*)(lds + PG8_SA(b, h) + aoff + m * 2048 + k * 1024); } while (0)
#define PG8_LDB(dst, b, h) do { _Pragma("unroll") for (int n = 0; n < 2; ++n) _Pragma("unroll") for (int k = 0; k < 2; ++k) dst[n][k] = *(const PG8_LAS bf16x8*)(lds + PG8_SB(b, h) + boff + n * 2048 + k * 1024); } while (0)
#define PG8_MMA(ai, bj, At, Bt) do { __builtin_amdgcn_s_setprio(1); _Pragma("unroll") for (int m = 0; m < 4; ++m) _Pragma("unroll") for (int n = 0; n < 2; ++n) _Pragma("unroll") for (int k = 0; k < 2; ++k) \
        acc[ai][bj][m][n] = __builtin_amdgcn_mfma_f32_16x16x32_bf16(Bt[n][k], At[m][k], acc[ai][bj][m][n], 0, 0, 0); __builtin_amdgcn_s_setprio(0); } while (0)
#define PG8_WAIT_V(n) asm volatile("s_waitcnt vmcnt(" #n ")" ::: "memory")
#define PG8_WAIT_L(n) asm volatile("s_waitcnt lgkmcnt(" #n ")" ::: "memory")
#define PG8_BAR __builtin_amdgcn_s_barrier()
#define PG8_SCHED __builtin_amdgcn_sched_barrier(0)
    Unit cur, nxt; int ui = 0;
    if (!S.next(0, cur)) return;
    f32x4 acc[2][2][4][2];
#pragma unroll
    for (int a = 0; a < 2; ++a)
#pragma unroll
        for (int b = 0; b < 2; ++b)
#pragma unroll
            for (int m = 0; m < 4; ++m)
#pragma unroll
                for (int n = 0; n < 2; ++n) acc[a][b][m][n] = (f32x4){0.f, 0.f, 0.f, 0.f};
    bf16x8 At[4][2], B0[2][2], B1[2][2];
    const char* cA = (const char*)g.A + (size_t)cur.pm * tstep; const char* cB = (const char*)g.Bt + (size_t)cur.pn * tstep;
    S.a_ready(cur);
    if constexpr (SP2) {
        PG8_STAGE(PG8_SB(0, 0), cB, voffB); PG8_STAGE(PG8_SB(0, 1), cB + hstep, voffB); PG8_STAGE(PG8_SA(0, 0), cA, voffA); PG8_STAGE(PG8_SA(0, 1), cA + hstep, voffA);
        if (wr == 1) PG8_BAR;
        PG8_WAIT_V(2); PG8_BAR;
        PG8_STAGE(PG8_SB(1, 0), cB + kstep, voffB); PG8_STAGE(PG8_SA(1, 0), cA + kstep, voffA); PG8_STAGE(PG8_SB(1, 1), cB + hstep + kstep, voffB);
        PG8_WAIT_V(6); PG8_BAR;
    } else {
        PG8_STAGE(PG8_SB(0, 0), cB, voffB); PG8_STAGE(PG8_SA(0, 0), cA, voffA); PG8_STAGE(PG8_SB(0, 1), cB + hstep, voffB); PG8_STAGE(PG8_SA(0, 1), cA + hstep, voffA);
        if (wr == 1) PG8_BAR;
        PG8_WAIT_V(4); PG8_BAR;
        PG8_STAGE(PG8_SB(1, 0), cB + kstep, voffB); PG8_STAGE(PG8_SA(1, 0), cA + kstep, voffA); PG8_STAGE(PG8_SB(1, 1), cB + hstep + kstep, voffB);
        PG8_WAIT_V(6); PG8_BAR;
    }
    for (;;) {
        const bool has_next = S.next(ui + 1, nxt);
        const char* nA = has_next ? (const char*)g.A + (size_t)nxt.pm * tstep : cA; const char* nB = has_next ? (const char*)g.Bt + (size_t)nxt.pn * tstep : cB;
        for (int t = 0; t < nt; t += 2) {
            const bool last = (t == nt - 2);
            const char* a1 = cA + (size_t)(t + 1) * kstep;
            const char* a2 = last ? nA : cA + (size_t)(t + 2) * kstep; const char* b2 = last ? nB : cB + (size_t)(t + 2) * kstep;
            const char* a3 = a2 + kstep; const char* b3 = b2 + kstep;
            if (last && has_next) S.a_ready(nxt);
            if constexpr (SP2) {
            PG8_LDB(B0, 0, 0); PG8_LDB(B1, 0, 1); PG8_SCHED; PG8_LDA(At, 0, 0); PG8_STAGE(PG8_SA(1, 1), a1 + hstep, voffA);
            PG8_WAIT_V(8); PG8_WAIT_L(0); PG8_BAR; PG8_MMA(0, 0, At, B0); PG8_MMA(0, 1, At, B1); PG8_BAR; PG8_SCHED;
            PG8_LDA(At, 0, 1); PG8_STAGE(PG8_SB(0, 0), b2, voffB); PG8_STAGE(PG8_SB(0, 1), b2 + hstep, voffB); PG8_STAGE(PG8_SA(0, 0), a2, voffA);
            PG8_WAIT_V(8); PG8_WAIT_L(0); PG8_BAR; PG8_MMA(1, 0, At, B0); PG8_MMA(1, 1, At, B1); PG8_BAR; PG8_SCHED;
            PG8_LDB(B0, 1, 0); PG8_LDB(B1, 1, 1); PG8_SCHED; PG8_LDA(At, 1, 0); PG8_STAGE(PG8_SA(0, 1), a2 + hstep, voffA);
            PG8_WAIT_V(8); PG8_WAIT_L(0); PG8_BAR; PG8_MMA(0, 0, At, B0); PG8_MMA(0, 1, At, B1); PG8_BAR; PG8_SCHED;
            PG8_LDA(At, 1, 1); PG8_STAGE(PG8_SB(1, 0), b3, voffB); PG8_STAGE(PG8_SB(1, 1), b3 + hstep, voffB); PG8_STAGE(PG8_SA(1, 0), a3, voffA);
            PG8_WAIT_V(8); PG8_WAIT_L(0); PG8_BAR; PG8_MMA(1, 0, At, B0); PG8_MMA(1, 1, At, B1); PG8_BAR; PG8_SCHED;
            } else {
            PG8_LDB(B0, 0, 0); PG8_SCHED; PG8_LDA(At, 0, 0); PG8_STAGE(PG8_SA(1, 1), a1 + hstep, voffA);
            PG8_WAIT_L(8); PG8_BAR; PG8_WAIT_L(0); PG8_MMA(0, 0, At, B0); PG8_BAR; PG8_SCHED;
            PG8_LDB(B1, 0, 1); PG8_STAGE(PG8_SB(0, 0), b2, voffB);
            PG8_BAR; PG8_WAIT_L(0); PG8_MMA(0, 1, At, B1); PG8_BAR;
            PG8_LDA(At, 0, 1); PG8_STAGE(PG8_SA(0, 0), a2, voffA);
            PG8_BAR; PG8_WAIT_L(0); PG8_MMA(1, 0, At, B0); PG8_BAR; PG8_SCHED;
            PG8_STAGE(PG8_SB(0, 1), b2 + hstep, voffB);
            PG8_WAIT_V(6); PG8_BAR; PG8_MMA(1, 1, At, B1); PG8_BAR;
            PG8_LDB(B0, 1, 0); PG8_SCHED; PG8_LDA(At, 1, 0); PG8_STAGE(PG8_SA(0, 1), a2 + hstep, voffA);
            PG8_WAIT_L(8); PG8_BAR; PG8_WAIT_L(0); PG8_MMA(0, 0, At, B0); PG8_BAR; PG8_SCHED;
            PG8_LDB(B1, 1, 1); PG8_STAGE(PG8_SB(1, 0), b3, voffB);
            PG8_BAR; PG8_WAIT_L(0); PG8_MMA(0, 1, At, B1); PG8_BAR;
            PG8_LDA(At, 1, 1); PG8_STAGE(PG8_SA(1, 0), a3, voffA);
            PG8_BAR; PG8_WAIT_L(0); PG8_MMA(1, 0, At, B0); PG8_BAR; PG8_SCHED;
            PG8_STAGE(PG8_SB(1, 1), b3 + hstep, voffB);
            PG8_WAIT_V(6); PG8_BAR; PG8_MMA(1, 1, At, B1); PG8_BAR;
            }
        }
        if constexpr (ALIGN_EPI) { if (wr == 0) PG8_BAR; }
        if constexpr (!Epi::AFTER_DRAIN) { E(acc, cur, wr, wc, fr, fq); S.done(cur); }
        if (!has_next) break;
#pragma unroll
        for (int a = 0; a < 2; ++a)
#pragma unroll
            for (int b = 0; b < 2; ++b)
#pragma unroll
                for (int m = 0; m < 4; ++m)
#pragma unroll
                    for (int n = 0; n < 2; ++n) acc[a][b][m][n] = (f32x4){0.f, 0.f, 0.f, 0.f};
        cur = nxt; cA = nA; cB = nB; ++ui;
        if constexpr (ALIGN_EPI) { if (wr == 1) PG8_BAR; }
    }
    PG8_WAIT_V(0);
    if constexpr (!ALIGN_EPI) { if (wr == 0) PG8_BAR; }
    PG8_BAR;
    if constexpr (Epi::AFTER_DRAIN) { E.fused(acc, cur, wr, wc, fr, fq, lds, wid, lane); S.done(cur); }
#undef PG8_SA
#undef PG8_SB
#undef PG8_STAGE
#undef PG8_LDA
#undef PG8_LDB
#undef PG8_MMA
#undef PG8_WAIT_V
#undef PG8_WAIT_L
#undef PG8_BAR
#undef PG8_SCHED
}
}
namespace hk {
typedef unsigned short bf16;
typedef short bf16x8 __attribute__((ext_vector_type(8)));
typedef float f32x4 __attribute__((ext_vector_type(4)));
typedef unsigned u32x4 __attribute__((ext_vector_type(4)));
typedef unsigned u32x2 __attribute__((ext_vector_type(2)));

constexpr int M = 49152, MP = 16384;
constexpr float EPS = 1e-6f;
constexpr size_t MiB = 1u << 20;
constexpr size_t WS_PART = 29 * MiB;
constexpr size_t WS_CDEC = 0;
constexpr size_t WS_BAR = 800 * 1024;
constexpr size_t WS_DT = 1 * MiB;
constexpr size_t WS_WIN = 4 * MiB, WS_WOUT = 10 * MiB, WS_WGU = 12 * MiB, WS_WDN = 23 * MiB;
constexpr size_t WS_XN = 32 * MiB;
constexpr size_t WS_QK = 128 * MiB, WS_VZ = 224 * MiB, WS_XBC = 320 * MiB;
constexpr size_t WS_HID = 128 * MiB;
constexpr size_t WS_MIX = 416 * MiB;
constexpr size_t WS_END = 512 * MiB;
constexpr size_t DO_XT = 0, DO_BROW = 48 * MiB, DO_BT = 72 * MiB, DO_CROW = 96 * MiB, DO_VT = 120 * MiB;

struct Params { const float* in[20]; float* out; unsigned char* ws; };

__device__ __forceinline__ float bf2f(unsigned v) { return __uint_as_float(v << 16); }
typedef float f32x2_t __attribute__((ext_vector_type(2))); typedef __bf16 bf16x2_t __attribute__((ext_vector_type(2)));
__device__ __forceinline__ unsigned pk2c(float lo, float hi) { f32x2_t v = {lo, hi}; bf16x2_t b = __builtin_convertvector(v, bf16x2_t); return __builtin_bit_cast(unsigned, b); }
__device__ __forceinline__ unsigned pk2(float lo, float hi) { return pg8::cvt_pk_bf16(lo, hi); }
__device__ __forceinline__ unsigned short f2bf(float f) { return (unsigned short)(pk2(f, 0.f) & 0xffffu); }
__device__ __forceinline__ f32x4 mfma16(bf16x8 a, bf16x8 b, f32x4 c) { return __builtin_amdgcn_mfma_f32_16x16x32_bf16(a, b, c, 0, 0, 0); }
__device__ __forceinline__ float wave_sum(float v) {
#pragma unroll
    for (int o = 1; o < 64; o <<= 1) v += __shfl_xor(v, o);
    return v;
}
__device__ __forceinline__ float silu(float x) { return x * __builtin_amdgcn_rcpf(1.f + __expf(-x)); }
__device__ __forceinline__ bf16x8 pack8(const float (&f)[8]) {
    u32x4 w; w.x = pk2(f[0], f[1]); w.y = pk2(f[2], f[3]); w.z = pk2(f[4], f[5]); w.w = pk2(f[6], f[7]);
    return __builtin_bit_cast(bf16x8, w);
}
__device__ __forceinline__ bf16x8 pack8m(const float (&f)[8]) {
    u32x4 w; w.x = pk2c(f[0], f[1]); w.y = pk2c(f[2], f[3]); w.z = pk2c(f[4], f[5]); w.w = pk2c(f[6], f[7]);
    return __builtin_bit_cast(bf16x8, w);
}
#define LDS_WAIT() asm volatile("s_waitcnt lgkmcnt(0)" ::: "memory")
__device__ __forceinline__ void mfma_operand_pad(bf16x8& f) { asm volatile("s_nop 7" : "+v"(f)); }

__device__ __forceinline__ void wave_scan2(float a0, float a1, int lane, float& p0, float& p1, float& tot) {
    const float s = a0 + a1; float inc = s;
#pragma unroll
    for (int o = 1; o < 64; o <<= 1) { const float t = __shfl_up(inc, o); if (lane >= o) inc += t; }
    const float excl = inc - s;
    p0 = excl + a0; p1 = p0 + a1; tot = __shfl(inc, 63);
}

__device__ __forceinline__ void tr_item(const float* __restrict__ W, int ldw, int K, int col0, bf16* WT, int dstrow0, const float* __restrict__ kscale, float* scr, int k0, int lane) {
#pragma unroll 8
    for (int i = 0; i < 32; ++i) { const int kk = 2 * i + (lane >> 5); scr[kk * 33 + (lane & 31)] = W[(size_t)(k0 + kk) * ldw + col0 + (lane & 31)]; }
    LDS_WAIT();
    const int c = lane & 7;
    float ks[8];
#pragma unroll
    for (int i = 0; i < 8; ++i) ks[i] = kscale ? kscale[k0 + 8 * c + i] : 1.f;
#pragma unroll
    for (int j = 0; j < 4; ++j) { const int n = (lane >> 3) + 8 * j; const float* s = scr + (8 * c) * 33 + n;
        u32x4 o; o.x = pk2(s[0 * 33] * ks[0], s[1 * 33] * ks[1]); o.y = pk2(s[2 * 33] * ks[2], s[3 * 33] * ks[3]);
        o.z = pk2(s[4 * 33] * ks[4], s[5 * 33] * ks[5]); o.w = pk2(s[6 * 33] * ks[6], s[7 * 33] * ks[7]);
        *(u32x4*)(WT + (size_t)(dstrow0 + n) * K + k0 + 8 * c) = o; }
    LDS_WAIT();
}

__device__ __forceinline__ void phase0(const Params& p, unsigned char* lds, int tid, int lane, int wave, int G) {
    const int gw = blockIdx.x * 8 + wave, NGW = G * 8;
    float* scr = (float*)(lds + 65536 + wave * 8448);
    const float* norm1_w = p.in[2]; const float* w_in = p.in[3]; const float* w_out = p.in[15]; const float* norm2_w = p.in[16];
    const float* w_gate = p.in[17]; const float* w_up = p.in[18]; const float* w_down = p.in[19];
    bf16* Win_t = (bf16*)(p.ws + WS_WIN); bf16* Wout_t = (bf16*)(p.ws + WS_WOUT); bf16* Wgu_t = (bf16*)(p.ws + WS_WGU); bf16* Wdn_t = (bf16*)(p.ws + WS_WDN);
    constexpr int I_IN = 16 * 96, I_OUT = 16 * 32, I_G = 16 * 88, I_DN = 44 * 32, NIT = I_IN + I_OUT + 2 * I_G + I_DN;
    for (int it = gw; it < NIT; it += NGW) {
        int r = it;
        if (r < I_IN) { const int kb = r / 96, nb = r % 96; tr_item(w_in, 3088, 1024, nb * 32, Win_t, nb * 32, norm1_w, scr, kb * 64, lane); continue; } r -= I_IN;
        if (r < I_OUT) { const int kb = r / 32, nb = r % 32; tr_item(w_out, 1024, 1024, nb * 32, Wout_t, nb * 32, nullptr, scr, kb * 64, lane); continue; } r -= I_OUT;
        if (r < I_G) { const int kb = r / 88, nb = r % 88, c0 = nb * 32; tr_item(w_gate, 2816, 1024, c0, Wgu_t, (c0 >> 7) * 256 + (c0 & 127), norm2_w, scr, kb * 64, lane); continue; } r -= I_G;
        if (r < I_G) { const int kb = r / 88, nb = r % 88, c0 = nb * 32; tr_item(w_up, 2816, 1024, c0, Wgu_t, (c0 >> 7) * 256 + 128 + (c0 & 127), norm2_w, scr, kb * 64, lane); continue; } r -= I_G;
        { const int kb = r / 32, nb = r % 32; tr_item(w_down, 1024, 2816, nb * 32, Wdn_t, nb * 32, nullptr, scr, kb * 64, lane); }
    }
    float* wdt = (float*)lds;
    for (int idx = tid; idx < 16384; idx += 512) { const int col = idx >> 4, o = idx & 15; wdt[o * 1024 + col] = w_in[(size_t)col * 3088 + 3072 + o] * norm1_w[col]; }
    __syncthreads();
    const float* xp = p.in[0]; const float* xs = p.in[1]; const float* dtbf = p.in[9]; const float* dtbb = p.in[10];
    bf16* XN = (bf16*)(p.ws + WS_XN); float* DT = (float*)(p.ws + WS_DT);
    f32x4 vn[4];
    { const float* xr = gw < MP ? xp + (size_t)gw * 1024 : xs + (size_t)(gw - MP) * 1024;
#pragma unroll
        for (int j = 0; j < 4; ++j) vn[j] = ((const f32x4*)xr)[64 * j + lane]; }
    const int oidx = ((lane >> 5) & 1) * 8 + ((lane >> 4) & 1) * 4 + ((lane >> 3) & 1) * 2 + ((lane >> 2) & 1);
    const float obias = oidx < 8 ? dtbf[oidx] : dtbb[oidx - 8];
    for (int row = gw; row < M; row += NGW) {
        f32x4 v[4]; float ss = 0.f;
#pragma unroll
        for (int j = 0; j < 4; ++j) { v[j] = vn[j]; ss += (v[j].x * v[j].x + v[j].y * v[j].y) + (v[j].z * v[j].z + v[j].w * v[j].w); }
        { const int nrow = row + NGW;
            if (nrow < M) { const float* xr = nrow < MP ? xp + (size_t)nrow * 1024 : xs + (size_t)(nrow - MP) * 1024;
#pragma unroll
                for (int j = 0; j < 4; ++j) vn[j] = ((const f32x4*)xr)[64 * j + lane]; } }
        const float rstd = rsqrtf(wave_sum(ss) * (1.f / 1024.f) + EPS);
#pragma unroll
        for (int j = 0; j < 4; ++j) { v[j] = v[j] * rstd; u32x2 o; o.x = pk2(v[j].x, v[j].y); o.y = pk2(v[j].z, v[j].w); ((u32x2*)(XN + (size_t)row * 1024))[64 * j + lane] = o; }
        float part[16];
#pragma unroll
        for (int o = 0; o < 16; ++o) { float acc = 0.f;
#pragma unroll
            for (int j = 0; j < 4; ++j) { const f32x4 w = *(const f32x4*)(wdt + o * 1024 + 256 * j + 4 * lane); acc += (v[j].x * w.x + v[j].y * w.y) + (v[j].z * w.z + v[j].w * w.w); }
            part[o] = acc; }
        float r8[8], r4[4], r2[2];
#pragma unroll
        for (int o = 0; o < 8; ++o) { const bool hi = (lane & 32) != 0; const float send = hi ? part[o] : part[o + 8], keep = hi ? part[o + 8] : part[o]; r8[o] = keep + __shfl_xor(send, 32); }
#pragma unroll
        for (int o = 0; o < 4; ++o) { const bool hi = (lane & 16) != 0; const float send = hi ? r8[o] : r8[o + 4], keep = hi ? r8[o + 4] : r8[o]; r4[o] = keep + __shfl_xor(send, 16); }
#pragma unroll
        for (int o = 0; o < 2; ++o) { const bool hi = (lane & 8) != 0; const float send = hi ? r4[o] : r4[o + 2], keep = hi ? r4[o + 2] : r4[o]; r2[o] = keep + __shfl_xor(send, 8); }
        float r1; { const bool hi = (lane & 4) != 0; const float send = hi ? r2[0] : r2[1], keep = hi ? r2[1] : r2[0]; r1 = keep + __shfl_xor(send, 4); }
        r1 += __shfl_xor(r1, 1); r1 += __shfl_xor(r1, 2);
        if ((lane & 3) == 0) { const float x = r1 + obias; DT[(size_t)row * 16 + oidx] = fmaxf(x, 0.f) + log1pf(__expf(-fabsf(x))); }
    }
}

__device__ __forceinline__ void conv_load(const Params& p, int u, int tid, bf16x8 (&pre)[3], float& wpre) {
    const int c = u >> 4, sb = u & 15, t0 = c * 128;
    wpre = 0.f; if (tid < 320) wpre = p.in[7][(tid >> 6) * 1024 + sb * 64 + (tid & 63)]; else if (tid < 384) wpre = p.in[8][sb * 64 + (tid - 320)];
    const bool first = (c < 128) ? ((c & 63) == 0) : (((c - 128) & 15) == 0);
    const bool last = (c < 128) ? ((c & 63) == 63) : (((c - 128) & 15) == 15);
    const bf16* XBC = (const bf16*)(p.ws + WS_XBC);
#pragma unroll
    for (int k = 0; k < 3; ++k) { const int idx = tid + 512 * k; const int rr = idx >> 3, seg = idx & 7; const int t = t0 - 2 + rr;
        const bool ok = (idx < 132 * 8) && (rr >= 2 || !first) && (rr < 130 || !last);
        bf16x8 v = {0, 0, 0, 0, 0, 0, 0, 0}; if (ok) v = *(const bf16x8*)(XBC + (size_t)t * 1024 + sb * 64 + seg * 8);
        pre[k] = v; }
}
__device__ __forceinline__ void conv_unit(const Params& p, unsigned char* lds, int u, int unext, int tid, bf16x8 (&pre)[3], float& wpre) {
    const int c = u >> 4, sb = u & 15, t0 = c * 128;
    float* raw = (float*)lds;
#pragma unroll
    for (int k = 0; k < 3; ++k) { const int idx = tid + 512 * k; const int rr = idx >> 3, seg = idx & 7;
        if (idx < 132 * 8) {
#pragma unroll
            for (int j = 0; j < 8; ++j) raw[rr * 65 + seg * 8 + j] = bf2f((unsigned short)pre[k][j]); } }
    float* wl = raw + 132 * 65;
    if (tid < 384) wl[tid] = wpre;
    __syncthreads();
    if (unext < 384 * 16) conv_load(p, unext, tid, pre, wpre);
    unsigned char* dout = (unsigned char*)p.out;
    {
        const int ch = tid & 63, l0 = (tid >> 6) * 16;
        const float w0 = wl[ch], w1 = wl[64 + ch], w2 = wl[128 + ch], w3 = wl[192 + ch], w4 = wl[256 + ch], b = wl[320 + ch];
        float rv[20];
#pragma unroll
        for (int k = 0; k < 20; ++k) rv[k] = raw[(l0 + k) * 65 + ch];
        float ov[16];
#pragma unroll
        for (int j = 0; j < 16; ++j) ov[j] = silu(b + rv[j] * w0 + rv[j + 1] * w1 + rv[j + 2] * w2 + rv[j + 3] * w3 + rv[j + 4] * w4);
        if (sb >= 8) {
            bf16* dst = ((sb < 12) ? (bf16*)(dout + DO_BROW) + (sb - 8) * 64 + ch : (bf16*)(dout + DO_CROW) + (sb - 12) * 64 + ch) + (size_t)(t0 + l0) * 256;
#pragma unroll
            for (int j = 0; j < 16; ++j) dst[(size_t)j * 256] = f2bf(ov[j]);
        }
        if (sb < 12) {
            bf16* dstT = ((sb < 8) ? (bf16*)(dout + DO_XT) + (size_t)(c * 8 + sb) * 8192 + ch * 128
                                   : (bf16*)(dout + DO_BT) + ((size_t)(c * 2 + ((sb - 8) >> 1)) * 128 + ((sb - 8) & 1) * 64 + ch) * 128) + l0;
            u32x4 o0, o1;
            o0.x = pk2(ov[0], ov[1]); o0.y = pk2(ov[2], ov[3]); o0.z = pk2(ov[4], ov[5]); o0.w = pk2(ov[6], ov[7]);
            o1.x = pk2(ov[8], ov[9]); o1.y = pk2(ov[10], ov[11]); o1.z = pk2(ov[12], ov[13]); o1.w = pk2(ov[14], ov[15]);
            *(u32x4*)dstT = o0; *(u32x4*)(dstT + 8) = o1;
        }
    }
    __syncthreads();
}

__device__ __forceinline__ void phase2(const Params& p, unsigned char* lds, int tid, int lane, int wave, int G) {
    { bf16x8 pre[3]; float wpre; conv_load(p, blockIdx.x, tid, pre, wpre);
      for (int u = blockIdx.x; u < 384 * 16; u += G) conv_unit(p, lds, u, u + G, tid, pre, wpre); }
    const int gw = blockIdx.x * 8 + wave, NGW = G * 8;
    bf16* QK = (bf16*)(p.ws + WS_QK); const float* qw = p.in[4]; const float* kw = p.in[5];
    for (int row0 = gw; row0 < M; row0 += 4 * NGW) {
        bf16x8 vv[4][2];
#pragma unroll
        for (int r = 0; r < 4; ++r)
#pragma unroll
            for (int pass = 0; pass < 2; ++pass) { const int row = row0 + r * NGW; if (row < M) vv[r][pass] = *(const bf16x8*)(QK + (size_t)row * 1024 + pass * 512 + lane * 8); }
#pragma unroll
        for (int r = 0; r < 4; ++r)
#pragma unroll
            for (int pass = 0; pass < 2; ++pass) { const int row = row0 + r * NGW; if (row >= M) continue;
                float f[8]; float ss = 0.f;
#pragma unroll
                for (int j = 0; j < 8; ++j) { f[j] = bf2f((unsigned short)vv[r][pass][j]); ss += f[j] * f[j]; }
                ss += __shfl_xor(ss, 1); ss += __shfl_xor(ss, 2); ss += __shfl_xor(ss, 4);
                const float rstd = rsqrtf(ss * (1.f / 64.f) + EPS) * (pass == 0 ? 0.125f : 1.f);
                const float* w = (pass ? kw : qw) + (lane & 7) * 8;
#pragma unroll
                for (int j = 0; j < 8; ++j) f[j] = f[j] * rstd * w[j];
                *(bf16x8*)(QK + (size_t)row * 1024 + pass * 512 + lane * 8) = pack8(f); }
    }
    const bf16* VZ = (const bf16*)(p.ws + WS_VZ); bf16* VT = (bf16*)((unsigned char*)p.out + DO_VT);
    unsigned short* scr = (unsigned short*)(lds + 65536 + wave * 8448);
    for (int it = gw; it < 768 * 8; it += NGW) { const int R = it >> 3, h = it & 7;
        const bf16* src = VZ + (size_t)(R * 64 + lane) * 1024 + h * 64;
#pragma unroll
        for (int seg = 0; seg < 8; ++seg) { const bf16x8 v = *(const bf16x8*)(src + seg * 8);
#pragma unroll
            for (int j = 0; j < 8; ++j) scr[lane * 66 + seg * 8 + j] = (unsigned short)v[j]; }
        LDS_WAIT();
#pragma unroll
        for (int seg = 0; seg < 8; ++seg) { u32x4 o;
            o.x = (unsigned)scr[(seg * 8 + 0) * 66 + lane] | ((unsigned)scr[(seg * 8 + 1) * 66 + lane] << 16);
            o.y = (unsigned)scr[(seg * 8 + 2) * 66 + lane] | ((unsigned)scr[(seg * 8 + 3) * 66 + lane] << 16);
            o.z = (unsigned)scr[(seg * 8 + 4) * 66 + lane] | ((unsigned)scr[(seg * 8 + 5) * 66 + lane] << 16);
            o.w = (unsigned)scr[(seg * 8 + 6) * 66 + lane] | ((unsigned)scr[(seg * 8 + 7) * 66 + lane] << 16);
            *(u32x4*)(VT + ((size_t)it * 64 + lane) * 64 + seg * 8) = o; }
        LDS_WAIT();
    }
}
__device__ __forceinline__ void attn_unit(const Params& p, const float* rpbs, unsigned short* ost, int R, int h, int qbs, int lane) {
    const bf16* QK = (const bf16*)(p.ws + WS_QK); const bf16* VT = (const bf16*)((const unsigned char*)p.out + DO_VT); bf16* MIX = (bf16*)(p.ws + WS_MIX);
    int r, rows; if (R < 256) { r = R & 127; rows = 128; } else { r = (R - 256) & 31; rows = 32; }
    const int Rb = R - r;
    int r0 = r - 4; r0 = r0 < 0 ? 0 : r0; r0 = r0 > rows - 8 ? rows - 8 : r0;
    const int fr = lane & 15, quad = lane >> 4;
    for (int qb = qbs; qb < qbs + 2; ++qb) {
        const int kc0 = (qb == 0) ? 0 : (qb == 1 ? 8 : (qb == 2 ? 24 : 32));
        const int qc = qb * 16 + fr;
        const bf16* qp = QK + (size_t)(R * 64 + qc) * 1024 + h * 64 + quad * 8;
        bf16x8 qf0 = *(const bf16x8*)qp, qf1 = *(const bf16x8*)(qp + 32); mfma_operand_pad(qf0); mfma_operand_pad(qf1);
        f32x4 st[8][2];
#pragma unroll
        for (int i = 0; i < 8; ++i)
#pragma unroll
            for (int t = 0; t < 2; ++t) { const int kcm = kc0 + (fr >> 2) * 8 + 4 * t + (fr & 3);
                const bf16* kp = QK + (size_t)((Rb + r0 + i) * 64 + kcm) * 1024 + 512 + h * 64 + quad * 8;
                bf16x8 k0 = *(const bf16x8*)kp, k1 = *(const bf16x8*)(kp + 32); mfma_operand_pad(k0); mfma_operand_pad(k1);
                f32x4 a = {0.f, 0.f, 0.f, 0.f}; a = mfma16(k0, qf0, a); a = mfma16(k1, qf1, a); st[i][t] = a; }
        int c0q = qc - 8; c0q = c0q < 0 ? 0 : c0q; c0q = c0q > 48 ? 48 : c0q;
        float mx = -1e30f;
#pragma unroll
        for (int i = 0; i < 8; ++i)
#pragma unroll
            for (int t = 0; t < 2; ++t)
#pragma unroll
                for (int e = 0; e < 4; ++e) { const int kc = kc0 + quad * 8 + 4 * t + e; const bool valid = (kc >= c0q) && (kc < c0q + 16);
                    int dc = kc - qc + 15; dc = dc < 0 ? 0 : dc; dc = dc > 30 ? 30 : dc;
                    const float bv = rpbs[(h * 15 + (r0 + i - r + 7)) * 31 + dc];
                    float s = st[i][t][e] + bv; s = valid ? s : -1e30f; st[i][t][e] = s; mx = fmaxf(mx, s); }
        mx = fmaxf(mx, __shfl_xor(mx, 16)); mx = fmaxf(mx, __shfl_xor(mx, 32));
        float sum = 0.f;
#pragma unroll
        for (int i = 0; i < 8; ++i)
#pragma unroll
            for (int t = 0; t < 2; ++t)
#pragma unroll
                for (int e = 0; e < 4; ++e) { const float pe = __expf(st[i][t][e] - mx); st[i][t][e] = pe; sum += pe; }
        sum += __shfl_xor(sum, 16); sum += __shfl_xor(sum, 32);
        const float inv = 1.f / sum;
        f32x4 o[4];
#pragma unroll
        for (int dt = 0; dt < 4; ++dt) o[dt] = (f32x4){0.f, 0.f, 0.f, 0.f};
#pragma unroll
        for (int i = 0; i < 8; ++i) {
            float pv[8];
#pragma unroll
            for (int e = 0; e < 4; ++e) { pv[e] = st[i][0][e] * inv; pv[4 + e] = st[i][1][e] * inv; }
            bf16x8 pf = pack8(pv); mfma_operand_pad(pf);
#pragma unroll
            for (int dt = 0; dt < 4; ++dt) { const bf16* vp = VT + ((size_t)((Rb + r0 + i) * 8 + h) * 64 + dt * 16 + fr) * 64 + kc0 + quad * 8;
                bf16x8 vf = *(const bf16x8*)vp; mfma_operand_pad(vf); o[dt] = mfma16(pf, vf, o[dt]); }
        }
#pragma unroll
        for (int dt = 0; dt < 4; ++dt)
#pragma unroll
            for (int e = 0; e < 4; ++e) ost[(quad * 4 + e) * 72 + dt * 16 + fr] = f2bf(o[dt][e]);
        LDS_WAIT();
#pragma unroll
        for (int k = 0; k < 2; ++k) { const int row = k * 8 + (lane >> 3), ch = lane & 7;
            *(u32x4*)(MIX + (size_t)(R * 64 + qb * 16 + row) * 1024 + h * 64 + ch * 8) = *(const u32x4*)(ost + row * 72 + ch * 8); }
        LDS_WAIT();
    }
}

__device__ __forceinline__ void s1_unit(const Params& p, float* wts, int u, int lane, int wave) {
    const int c = u >> 3, h = u & 7, g = h >> 2, t0 = c * 128;
    const float* DT = (const float*)(p.ws + WS_DT); float* CDEC = (float*)(p.ws + WS_CDEC);
    if (wave < 2) { const int dir = wave;
        const float A = -__expf(dir ? p.in[12][h] : p.in[11][h]);
        const float d0 = DT[(size_t)(t0 + 2 * lane) * 16 + dir * 8 + h], d1 = DT[(size_t)(t0 + 2 * lane + 1) * 16 + dir * 8 + h];
        const float a0 = d0 * A, a1 = d1 * A; float p0, p1, tot; wave_scan2(a0, a1, lane, p0, p1, tot);
        float w0, w1;
        if (dir == 0) { w0 = __expf(tot - p0) * d0; w1 = __expf(tot - p1) * d1; }
        else { w0 = __expf(p0 - a0) * d0; w1 = __expf(p1 - a1) * d1; }
        wts[dir * 128 + 2 * lane] = w0; wts[dir * 128 + 2 * lane + 1] = w1;
        if (lane == 0) CDEC[((dir * 384 + c) * 8 + h) * 32] = __expf(tot);
    }
    PG8_LAS unsigned char* xtl = (PG8_LAS unsigned char*)(wts + 4096) + 2 * 64 * 136 * 2 + 2048;
    { const bf16* xsrc = (const bf16*)((const unsigned char*)p.out + DO_XT) + (size_t)(c * 8 + h) * 8192;
#pragma unroll
        for (int k = 0; k < 2; ++k) { const int q = wave * 2 + k, row = q * 4 + (lane >> 4);
            __builtin_amdgcn_global_load_lds((const unsigned*)(xsrc + row * 128 + (((lane & 15) ^ (row & 15)) * 8)), (PG8_LAS unsigned*)(xtl + q * 1024), 16, 0, 0); }
        asm volatile("s_waitcnt vmcnt(0)" ::: "memory"); }
    __syncthreads();
    const int fr = lane & 15, quad = lane >> 4;
    const bf16* XT = (const bf16*)((const unsigned char*)p.out + DO_XT); const bf16* BT = (const bf16*)((const unsigned char*)p.out + DO_BT);
    bf16* STATE = (bf16*)(p.ws + WS_XN);
    f32x4 acc[2][4];
#pragma unroll
    for (int d = 0; d < 2; ++d)
#pragma unroll
        for (int pt = 0; pt < 4; ++pt) acc[d][pt] = (f32x4){0.f, 0.f, 0.f, 0.f};
#pragma unroll
    for (int ks = 0; ks < 4; ++ks) {
        bf16x8 bfr = *(const bf16x8*)(BT + ((size_t)(c * 2 + g) * 128 + wave * 16 + fr) * 128 + ks * 32 + quad * 8); mfma_operand_pad(bfr);
        const f32x4 wf0 = *(const f32x4*)(wts + ks * 32 + quad * 8), wf1 = *(const f32x4*)(wts + ks * 32 + quad * 8 + 4);
        const f32x4 wb0 = *(const f32x4*)(wts + 128 + ks * 32 + quad * 8), wb1 = *(const f32x4*)(wts + 128 + ks * 32 + quad * 8 + 4);
#pragma unroll
        for (int pt = 0; pt < 4; ++pt) {
            const bf16x8 xf = *(const PG8_LAS bf16x8*)(xtl + (pt * 16 + fr) * 256 + (((ks * 4 + quad) ^ fr) * 16));
            float xv[8], sf[8], sb[8];
#pragma unroll
            for (int j = 0; j < 8; ++j) xv[j] = bf2f((unsigned short)xf[j]);
#pragma unroll
            for (int j = 0; j < 4; ++j) { sf[j] = xv[j] * wf0[j]; sf[4 + j] = xv[4 + j] * wf1[j]; sb[j] = xv[j] * wb0[j]; sb[4 + j] = xv[4 + j] * wb1[j]; }
            bf16x8 af = pack8(sf), ab = pack8(sb); mfma_operand_pad(af); mfma_operand_pad(ab);
            acc[0][pt] = mfma16(af, bfr, acc[0][pt]);
            acc[1][pt] = mfma16(ab, bfr, acc[1][pt]);
        }
    }
    unsigned short* stg = (unsigned short*)(wts + 4096);
#pragma unroll
    for (int d = 0; d < 2; ++d)
#pragma unroll
        for (int pt = 0; pt < 4; ++pt)
#pragma unroll
            for (int e = 0; e < 4; ++e) stg[(d * 64 + pt * 16 + quad * 4 + e) * 136 + wave * 16 + fr] = f2bf(acc[d][pt][e]);
    __syncthreads();
    { const int tid = wave * 64 + lane;
#pragma unroll
        for (int i = 0; i < 4; ++i) { const int piece = tid + 512 * i, row = piece >> 4, seg = piece & 15, d = row >> 6, pr = row & 63;
            const u32x4 v = *(const u32x4*)(stg + row * 136 + seg * 8);
            *(u32x4*)(STATE + ((((size_t)d * 384 + c) * 8 + h) * 64 + pr) * 128 + seg * 8) = v; } }
    __syncthreads();
}

__device__ __forceinline__ void phase_scan(const Params& p, int tid, int G) {
    bf16* STATE = (bf16*)(p.ws + WS_XN); const float* CDEC = (const float*)(p.ws + WS_CDEC);
    for (int gt = blockIdx.x * 512 + tid; gt < 131072; gt += G * 512) {
        if (gt < 65536) {
            const int e4 = gt & 2047, h = (gt >> 11) & 7, sd = gt >> 14, sq = sd & 1, dir = sd >> 1, c0 = sq * 64;
            const int cstep = dir ? -1 : 1, cfirst = dir ? c0 + 63 : c0;
            u32x2* base = (u32x2*)(STATE + ((size_t)dir * 384 * 8 + h) * 8192 + e4 * 4);
            const float* dbase = CDEC + (dir * 384 * 8 + h) * 32;
            float hs[4] = {0.f, 0.f, 0.f, 0.f};
            u32x2 qv[8]; float qd[8];
#pragma unroll
            for (int j = 0; j < 8; ++j) { const int c = cfirst + cstep * j; qv[j] = base[(size_t)c * 16384]; qd[j] = dbase[c * 256]; }
#pragma unroll 1
            for (int s0 = 0; s0 < 64; s0 += 8) {
#pragma unroll
                for (int j = 0; j < 8; ++j) { const int c = cfirst + cstep * (s0 + j);
                    const u32x2 v = qv[j]; const float dec = qd[j];
                    if (s0 + 8 < 64) { const int cn = c + cstep * 8; qv[j] = base[(size_t)cn * 16384]; qd[j] = dbase[cn * 256]; }
                    u32x2 o; o.x = pk2(hs[0], hs[1]); o.y = pk2(hs[2], hs[3]); base[(size_t)c * 16384] = o;
                    hs[0] = hs[0] * dec + bf2f(v.x & 0xffffu); hs[1] = hs[1] * dec + bf2f(v.x >> 16); hs[2] = hs[2] * dec + bf2f(v.y & 0xffffu); hs[3] = hs[3] * dec + bf2f(v.y >> 16); }
            }
        } else {
            const int k = gt - 65536;
            float hs[4][8];
#pragma unroll
            for (int j = 0; j < 4; ++j)
#pragma unroll
                for (int i = 0; i < 8; ++i) hs[j][i] = 0.f;
            bf16* cb[4]; const float* db[4]; int cstep[4];
#pragma unroll
            for (int j = 0; j < 4; ++j) { const int it = k + 65536 * j, e8 = it & 1023, h = (it >> 10) & 7, sd = it >> 13, dir = sd >> 4, c0 = 128 + (sd & 15) * 16;
                const int cf = dir ? c0 + 15 : c0; cstep[j] = dir ? -1 : 1;
                cb[j] = STATE + (((size_t)dir * 384 + cf) * 8 + h) * 8192 + e8 * 8; db[j] = CDEC + ((dir * 384 + cf) * 8 + h) * 32; }
            bf16x8 qv[2][4]; float qd[2][4];
#pragma unroll
            for (int d = 0; d < 2; ++d)
#pragma unroll
                for (int j = 0; j < 4; ++j) { qv[d][j] = *(const bf16x8*)(cb[j] + (ptrdiff_t)cstep[j] * d * 65536); qd[d][j] = db[j][cstep[j] * d * 256]; }
#pragma unroll 1
            for (int s0 = 0; s0 < 16; s0 += 2) {
#pragma unroll
                for (int d = 0; d < 2; ++d)
#pragma unroll
                    for (int j = 0; j < 4; ++j) { const int st = s0 + d;
                        const bf16x8 v = qv[d][j]; const float dec = qd[d][j];
                        if (s0 + 2 < 16) { qv[d][j] = *(const bf16x8*)(cb[j] + (ptrdiff_t)cstep[j] * (st + 2) * 65536); qd[d][j] = db[j][cstep[j] * (st + 2) * 256]; }
                        *(bf16x8*)(cb[j] + (ptrdiff_t)cstep[j] * st * 65536) = pack8(hs[j]);
#pragma unroll
                        for (int i = 0; i < 8; ++i) hs[j][i] = hs[j][i] * dec + bf2f((unsigned short)v[i]); }
            }
        }
    }
}

__device__ __forceinline__ void s3_unit(const Params& p, unsigned char* lds, int u, int lane, int wave) {
    const int c = u >> 1, g = u & 1, t0 = c * 128;
    float* acsf = (float*)lds; float* rcsb = acsf + 512; float* dtf = acsf + 1024; float* dtb = acsf + 1536;
    const float* DT = (const float*)(p.ws + WS_DT);
    { const int hl = wave & 3, dir = wave >> 2, h = g * 4 + hl;
        const float A = -__expf(dir ? p.in[12][h] : p.in[11][h]);
        const float d0 = DT[(size_t)(t0 + 2 * lane) * 16 + dir * 8 + h], d1 = DT[(size_t)(t0 + 2 * lane + 1) * 16 + dir * 8 + h];
        const float a0 = d0 * A, a1 = d1 * A; float p0, p1, tot; wave_scan2(a0, a1, lane, p0, p1, tot);
        if (dir == 0) { acsf[hl * 128 + 2 * lane] = p0; acsf[hl * 128 + 2 * lane + 1] = p1; dtf[hl * 128 + 2 * lane] = d0; dtf[hl * 128 + 2 * lane + 1] = d1; }
        else { rcsb[hl * 128 + 2 * lane] = tot - p0 + a0; rcsb[hl * 128 + 2 * lane + 1] = tot - p1 + a1; dtb[hl * 128 + 2 * lane] = d0; dtb[hl * 128 + 2 * lane + 1] = d1; }
    }
    __syncthreads();
    const int fr = lane & 15, quad = lane >> 4, lrow = 16 * wave + fr, l4 = 16 * wave + quad * 4;
    const unsigned char* dout = (const unsigned char*)p.out;
    const bf16* XT = (const bf16*)(dout + DO_XT); const bf16* BROW = (const bf16*)(dout + DO_BROW); const bf16* CROW = (const bf16*)(dout + DO_CROW);
    const bf16* STATE = (const bf16*)(p.ws + WS_XN); const bf16* VZ = (const bf16*)(p.ws + WS_VZ); bf16* MIX = (bf16*)(p.ws + WS_MIX);
    bf16x8 cf[4];
#pragma unroll
    for (int ks = 0; ks < 4; ++ks) { cf[ks] = *(const bf16x8*)(CROW + (size_t)(t0 + lrow) * 256 + g * 128 + ks * 32 + quad * 8); mfma_operand_pad(cf[ks]); }
    PG8_LAS unsigned char* tlb = (PG8_LAS unsigned char*)lds + 74240;
#pragma unroll
    for (int k = 0; k < 4; ++k) { const int q = wave * 4 + k, row = q * 4 + (lane >> 4);
        __builtin_amdgcn_global_load_lds((const unsigned*)(BROW + (size_t)(t0 + row) * 256 + g * 128 + (((lane & 15) ^ (row & 15)) * 8)), (PG8_LAS unsigned*)(tlb + q * 1024), 16, 0, 0); }
    asm volatile("s_waitcnt vmcnt(0)" ::: "memory");
    __syncthreads();
    f32x4 cb[4][2];
#pragma unroll
    for (int sp = 0; sp < 4; ++sp)
#pragma unroll
        for (int t = 0; t < 2; ++t) { const int srow = sp * 32 + (fr >> 2) * 8 + 4 * t + (fr & 3);
            f32x4 a = {0.f, 0.f, 0.f, 0.f};
#pragma unroll
            for (int ks = 0; ks < 4; ++ks) a = mfma16(*(const PG8_LAS bf16x8*)(tlb + srow * 256 + (((ks * 4 + quad) ^ (srow & 15)) * 16)), cf[ks], a);
            cb[sp][t] = a; }
    float ssq[4] = {0.f, 0.f, 0.f, 0.f};
    unsigned short* gsm = (unsigned short*)(lds + 8192 + wave * 8192);
    float* rsm = (float*)(lds + 8192 + 8 * 8192) + wave * 16;
    PG8_LAS unsigned char* tl = (PG8_LAS unsigned char*)lds + 74240;
    const int dj = lane >> 4;
    const int dcp = lane & 15;
    const float* nw = p.in[14];
#pragma unroll 1
    for (int hl = 0; hl < 4; ++hl) { const int h = g * 4 + hl;
        const bf16* xth = XT + (size_t)(c * 8 + h) * 8192;
        const bf16* stf = STATE + ((size_t)c * 8 + h) * 8192; const bf16* stb = stf + (size_t)384 * 8 * 8192;
        __syncthreads();
#pragma unroll
        for (int k = 0; k < 2; ++k) { const int row = (wave * 2 + k) * 4 + dj; const int so = row * 128 + ((dcp ^ (row & 15)) * 8);
            __builtin_amdgcn_global_load_lds((const unsigned*)(xth + so), (PG8_LAS unsigned*)(tl + (wave * 2 + k) * 1024), 16, 0, 0);
            __builtin_amdgcn_global_load_lds((const unsigned*)(stf + so), (PG8_LAS unsigned*)(tl + 16384 + (wave * 2 + k) * 1024), 16, 0, 0);
            __builtin_amdgcn_global_load_lds((const unsigned*)(stb + so), (PG8_LAS unsigned*)(tl + 32768 + (wave * 2 + k) * 1024), 16, 0, 0); }
        asm volatile("s_waitcnt vmcnt(0)" ::: "memory");
        __syncthreads();
        const float af_l = acsf[hl * 128 + lrow], rb_l = rcsb[hl * 128 + lrow];
        f32x4 Y[4];
        {
            f32x4 Yf[4], Yb[4];
#pragma unroll
            for (int pt = 0; pt < 4; ++pt) { Yf[pt] = (f32x4){0.f, 0.f, 0.f, 0.f}; Yb[pt] = Yf[pt]; }
#pragma unroll
            for (int ks = 0; ks < 4; ++ks) {
#pragma unroll
                for (int pt = 0; pt < 4; ++pt) {
                    const int lo = (pt * 16 + fr) * 256 + (((ks * 4 + quad) ^ fr) * 16);
                    Yf[pt] = mfma16(cf[ks], *(const PG8_LAS bf16x8*)(tl + 16384 + lo), Yf[pt]);
                    Yb[pt] = mfma16(cf[ks], *(const PG8_LAS bf16x8*)(tl + 32768 + lo), Yb[pt]);
                }
            }
            const f32x4 ea = *(const f32x4*)(acsf + hl * 128 + l4), eb = *(const f32x4*)(rcsb + hl * 128 + l4);
            f32x4 xa, xb;
#pragma unroll
            for (int e = 0; e < 4; ++e) { xa[e] = __expf(ea[e]); xb[e] = __expf(eb[e]); }
#pragma unroll
            for (int pt = 0; pt < 4; ++pt) Y[pt] = xa * Yf[pt] + xb * Yb[pt];
        }
#pragma unroll
        for (int sp = 0; sp < 4; ++sp) { const int s0 = sp * 32 + quad * 8;
            float mv[8];
#pragma unroll
            for (int t = 0; t < 2; ++t) {
                const f32x4 afs = *(const f32x4*)(acsf + hl * 128 + s0 + 4 * t), rbs = *(const f32x4*)(rcsb + hl * 128 + s0 + 4 * t);
                const f32x4 dfs = *(const f32x4*)(dtf + hl * 128 + s0 + 4 * t), dbs = *(const f32x4*)(dtb + hl * 128 + s0 + 4 * t);
#pragma unroll
                for (int e = 0; e < 4; ++e) { const int s = s0 + 4 * t + e;
                    const float ef = __expf(fminf(af_l - afs[e], 0.f)) * dfs[e], eb2 = __expf(fminf(rb_l - rbs[e], 0.f)) * dbs[e];
                    const float vf = (s <= lrow) ? ef : 0.f;
                    const float vb = (s >= lrow) ? eb2 : 0.f;
                    mv[4 * t + e] = cb[sp][t][e] * (vf + vb); }
            }
            bf16x8 mf = pack8(mv); mfma_operand_pad(mf);
#pragma unroll
            for (int pt = 0; pt < 4; ++pt) Y[pt] = mfma16(mf, *(const PG8_LAS bf16x8*)(tl + (pt * 16 + fr) * 256 + (((sp * 4 + quad) ^ fr) * 16)), Y[pt]);
        }
        const float Dk = p.in[13][h];
#pragma unroll
        for (int pt = 0; pt < 4; ++pt) { const int pc = pt * 16 + fr;
            const u32x2 xw = *(const u32x2*)(xth + (size_t)pc * 128 + l4);
            const float xv[4] = {bf2f(xw.x & 0xffffu), bf2f(xw.x >> 16), bf2f(xw.y & 0xffffu), bf2f(xw.y >> 16)};
            const float wn = nw[h * 64 + pc];
#pragma unroll
            for (int e = 0; e < 4; ++e) { const size_t off = (size_t)(t0 + l4 + e) * 1024 + 512 + h * 64 + pc;
                const float zv = bf2f(VZ[off]);
                const float y = Y[pt][e] + Dk * xv[e];
                const float gg = y * silu(zv); ssq[e] += gg * gg;
                gsm[(quad * 4 + e) * 256 + hl * 64 + pc] = f2bf(gg * wn); }
        }
    }
#pragma unroll
    for (int e = 0; e < 4; ++e) { float ss = ssq[e];
        ss += __shfl_xor(ss, 1); ss += __shfl_xor(ss, 2); ss += __shfl_xor(ss, 4); ss += __shfl_xor(ss, 8);
        if (fr == 0) rsm[quad * 4 + e] = rsqrtf(ss * (1.f / 256.f) + EPS); }
    LDS_WAIT();
    { const int r = lane >> 2; const float rs = rsm[r];
        bf16* mp = MIX + (size_t)(t0 + 16 * wave + r) * 1024 + 512 + g * 256 + (lane & 3) * 64;
        const unsigned short* gp = gsm + r * 256 + (lane & 3) * 64;
#pragma unroll
        for (int it = 0; it < 8; ++it) { const u32x4 w = *(const u32x4*)(gp + it * 8);
            u32x4 o; o.x = pk2(bf2f(w.x & 0xffffu) * rs, bf2f(w.x >> 16) * rs); o.y = pk2(bf2f(w.y & 0xffffu) * rs, bf2f(w.y >> 16) * rs);
            o.z = pk2(bf2f(w.z & 0xffffu) * rs, bf2f(w.z >> 16) * rs); o.w = pk2(bf2f(w.w & 0xffffu) * rs, bf2f(w.w >> 16) * rs);
            *(u32x4*)(mp + it * 8) = o; }
    }
    __syncthreads();
}
using pg8::Unit;
struct EpiProj {
    static constexpr bool PERM = true, AFTER_DRAIN = false;
    bf16* O;
    __device__ __forceinline__ void operator()(const f32x4 (&acc)[2][2][4][2], const Unit& u, int wr, int wc, int fr, int fq) const {
        const int row0 = u.pm * 256 + wr * 64 + fr; const int colt = u.pn * 256; const int piece = colt >> 10;
        bf16* base = O + (size_t)piece * ((size_t)M * 1024) + (colt & 1023) + wc * 32 + 8 * fq;
#pragma unroll
        for (int ai = 0; ai < 2; ++ai)
#pragma unroll
            for (int m = 0; m < 4; ++m) { bf16* rowp = base + (size_t)(row0 + ai * 128 + m * 16) * 1024;
#pragma unroll
                for (int bj = 0; bj < 2; ++bj) { const f32x4 v0 = acc[ai][bj][m][0], v1 = acc[ai][bj][m][1];
                    u32x4 w; w.x = pk2(v0[0], v0[1]); w.y = pk2(v0[2], v0[3]); w.z = pk2(v1[0], v1[1]); w.w = pk2(v1[2], v1[3]);
                    *(u32x4*)(rowp + bj * 128) = w; } }
    }
};
struct EpiOut {
    static constexpr bool PERM = true, AFTER_DRAIN = false;
    const float* xp; const float* xs; float* out; bf16* xb; float* rowss;
    __device__ __forceinline__ void operator()(const f32x4 (&acc)[2][2][4][2], const Unit& u, int wr, int wc, int fr, int fq) const {
        const int row0 = u.pm * 256 + wr * 64 + fr; const int col0 = u.pn * 256 + wc * 32 + 8 * fq;
#pragma unroll
        for (int ai = 0; ai < 2; ++ai)
#pragma unroll
            for (int m = 0; m < 4; ++m) { const int row = row0 + ai * 128 + m * 16;
                const float* xr = (row < MP ? xp + (size_t)row * 1024 : xs + (size_t)(row - MP) * 1024) + col0;
                float ss = 0.f;
#pragma unroll
                for (int bj = 0; bj < 2; ++bj) {
                    const f32x4 v0 = acc[ai][bj][m][0] + *(const f32x4*)(xr + bj * 128), v1 = acc[ai][bj][m][1] + *(const f32x4*)(xr + bj * 128 + 4);
                    float* op = out + (size_t)row * 1024 + col0 + bj * 128; *(f32x4*)op = v0; *(f32x4*)(op + 4) = v1;
                    u32x4 w; w.x = pk2(v0[0], v0[1]); w.y = pk2(v0[2], v0[3]); w.z = pk2(v1[0], v1[1]); w.w = pk2(v1[2], v1[3]);
                    *(u32x4*)(xb + (size_t)row * 1024 + col0 + bj * 128) = w;
                    ss += (v0[0] * v0[0] + v0[1] * v0[1]) + (v0[2] * v0[2] + v0[3] * v0[3]) + (v1[0] * v1[0] + v1[1] * v1[1]) + (v1[2] * v1[2] + v1[3] * v1[3]); }
                ss += __shfl_xor(ss, 16); ss += __shfl_xor(ss, 32);
                if (fq == 0) rowss[((size_t)u.pn * M + row) * 4 + wc] = ss; }
    }
};
struct EpiGU {
    static constexpr bool PERM = true, AFTER_DRAIN = false;
    bf16* hid; const float* rowss;
    __device__ __forceinline__ void operator()(const f32x4 (&acc)[2][2][4][2], const Unit& u, int wr, int wc, int fr, int fq) const {
        const int row0 = u.pm * 256 + wr * 64 + fr; const int col0 = u.pn * 128 + wc * 32 + 8 * fq;
#pragma unroll
        for (int ai = 0; ai < 2; ++ai)
#pragma unroll
            for (int m = 0; m < 4; ++m) { const int row = row0 + ai * 128 + m * 16;
                const f32x4* pp = (const f32x4*)(rowss + (size_t)row * 4); const f32x4 q0 = pp[0], q1 = pp[M], q2 = pp[2 * M], q3 = pp[3 * M];
                const float rsum = ((q0[0] + q0[1]) + (q0[2] + q0[3])) + ((q1[0] + q1[1]) + (q1[2] + q1[3])) + ((q2[0] + q2[1]) + (q2[2] + q2[3])) + ((q3[0] + q3[1]) + (q3[2] + q3[3]));
                const float rstd = rsqrtf(rsum * (1.f / 1024.f) + EPS);
                float hv[8];
#pragma unroll
                for (int n = 0; n < 2; ++n)
#pragma unroll
                    for (int e = 0; e < 4; ++e) { const float gt = acc[ai][0][m][n][e] * rstd, up = acc[ai][1][m][n][e] * rstd; hv[4 * n + e] = silu(gt) * up; }
                *(bf16x8*)(hid + (size_t)row * 2816 + col0) = pack8(hv); }
    }
};
struct EpiDown {
    static constexpr bool PERM = true, AFTER_DRAIN = false;
    float* out;
    __device__ __forceinline__ void operator()(const f32x4 (&acc)[2][2][4][2], const Unit& u, int wr, int wc, int fr, int fq) const {
        const int row0 = u.pm * 256 + wr * 64 + fr; const int col0 = u.pn * 256 + wc * 32 + 8 * fq;
#pragma unroll
        for (int ai = 0; ai < 2; ++ai)
#pragma unroll
            for (int m = 0; m < 4; ++m) { float* op = out + (size_t)(row0 + ai * 128 + m * 16) * 1024 + col0;
#pragma unroll
                for (int bj = 0; bj < 2; ++bj) { const f32x4 a0 = *(const f32x4*)(op + bj * 128), a1 = *(const f32x4*)(op + bj * 128 + 4);
                    *(f32x4*)(op + bj * 128) = a0 + acc[ai][bj][m][0]; *(f32x4*)(op + bj * 128 + 4) = a1 + acc[ai][bj][m][1]; } }
    }
};

#define LAS __attribute__((address_space(3)))
#define XB_TMO      128
#define XB_XCNT(j)  (256  + 64 * (j))
#define XB_XSUB(j)  (1280 + 64 * (j))
#define XB_XGEN(j)  (2304 + 64 * (j))
#define XB_TOP      3328
#define XB_TOPGEN   3392
#define XCD_BAR_WORDS 3456
#define XB_SPIN_CAP (1u << 18)

__device__ __forceinline__ unsigned xb_ld(unsigned* p)              { return __hip_atomic_load(p, __ATOMIC_RELAXED, __HIP_MEMORY_SCOPE_AGENT); }
__device__ __forceinline__ unsigned xb_add(unsigned* p, unsigned v) { return __hip_atomic_fetch_add(p, v, __ATOMIC_RELAXED, __HIP_MEMORY_SCOPE_AGENT); }
__device__ __forceinline__ unsigned xb_xcc_id() { return (unsigned)__builtin_amdgcn_s_getreg((3 << 11) | 20) & 0xFu; }
#define XB_SPIN(cond, bar) do { unsigned _sp = 0; while (cond) { __builtin_amdgcn_s_sleep(1); \
    if ((++_sp & 255u) == 0u) { if (xb_ld(&(bar)[XB_TMO])) break; if (_sp > XB_SPIN_CAP) { atomicAdd(&(bar)[XB_TMO], 1u); break; } } } } while (0)

struct XcdBarrier {
    unsigned* bar; unsigned x;
    volatile LAS unsigned* st;
};

__device__ __forceinline__ XcdBarrier xcd_barrier_post(unsigned* bar, volatile LAS unsigned* st) {
    XcdBarrier b; b.bar = bar; b.x = xb_xcc_id(); b.st = st;
    if (threadIdx.x == 0) (void)xb_add(&bar[XB_XCNT(b.x)], 1u);
    return b;
}
__device__ __forceinline__ void xcd_barrier_complete(unsigned* bar, unsigned x, unsigned& nloc, unsigned& nx) {
    const unsigned G = gridDim.x * gridDim.y * gridDim.z;
    unsigned sum, cnt, mine, sp = 0u;
    for (;;) {
        sum = 0u; cnt = 0u; mine = 0u;
#pragma unroll
        for (unsigned j = 0; j < 16; ++j) { const unsigned c = xb_ld(&bar[XB_XCNT(j)]); sum += c; cnt += (c > 0u) ? 1u : 0u; mine = (j == x) ? c : mine; }
        if (sum == G) break;
        __builtin_amdgcn_s_sleep(1);
        if ((++sp & 255u) == 0u) { if (xb_ld(&bar[XB_TMO])) break; if (sp > XB_SPIN_CAP) { atomicAdd(&bar[XB_TMO], 1u); break; } }
    }
    nloc = mine > 0u ? mine : 1u; nx = cnt > 0u ? cnt : 1u;
}

__device__ __forceinline__ void xcd_barrier(const XcdBarrier& b) {
    asm volatile("s_waitcnt vmcnt(0)" ::: "memory");
    __syncthreads();
    if (threadIdx.x == 0) {
        unsigned* bar = b.bar;
        __builtin_amdgcn_s_waitcnt(0);
        unsigned nloc = b.st[0], nx = b.st[1];
        if (nloc == 0u) { xcd_barrier_complete(bar, b.x, nloc, nx); b.st[0] = nloc; b.st[1] = nx; }
        const unsigned old = xb_add(&bar[XB_XSUB(b.x)], 1u);
        const unsigned gen = old / nloc;
        if (old + 1u == (gen + 1u) * nloc) {
            __builtin_amdgcn_fence(__ATOMIC_RELEASE, "agent");
            asm volatile("s_waitcnt vmcnt(0)" ::: "memory");
            const unsigned og = xb_add(&bar[XB_TOP], 1u);
            const unsigned tg = og / nx;
            if (og + 1u == (tg + 1u) * nx) xb_add(&bar[XB_TOPGEN], 1u);
            else XB_SPIN(xb_ld(&bar[XB_TOPGEN]) == tg, bar);
            __builtin_amdgcn_fence(__ATOMIC_ACQUIRE, "agent");
            xb_add(&bar[XB_XGEN(b.x)], 1u);
            asm volatile("s_waitcnt vmcnt(0)" ::: "memory");
        } else {
            XB_SPIN(xb_ld(&bar[XB_XGEN(b.x)]) == gen, bar);
            __builtin_amdgcn_fence(__ATOMIC_ACQUIRE, "agent");
            asm volatile("s_waitcnt vmcnt(0)" ::: "memory");
        }
    }
    __syncthreads();
}


__device__ __forceinline__ void gsync(cg::grid_group& grid) {
    asm volatile("s_waitcnt vmcnt(0) lgkmcnt(0)" ::: "memory");
    __syncthreads();
    grid.sync();
    __builtin_amdgcn_fence(__ATOMIC_ACQUIRE, "agent");
    asm volatile("s_waitcnt vmcnt(0)" ::: "memory");
    __syncthreads();
}
constexpr int LDS_BYTES = 147456;
__global__ void __launch_bounds__(512, 2) hymba_fwd(Params p) {
    extern __shared__ __attribute__((aligned(16))) unsigned char lds[];
    cg::grid_group grid = cg::this_grid();
    const int tid = threadIdx.x, lane = tid & 63, wave = __builtin_amdgcn_readfirstlane(tid >> 6), G = gridDim.x;
    PG8_LAS unsigned char* glds = (PG8_LAS unsigned char*)lds;
    volatile LAS unsigned* MISC = (volatile LAS unsigned*)((LAS unsigned char*)lds + (LDS_BYTES - 64));
    if (tid < 16) MISC[tid] = 0u;
    unsigned* barw = (unsigned*)(p.ws + WS_BAR);
    if (blockIdx.x == 0) for (int i = tid; i < XCD_BAR_WORDS; i += 512) __hip_atomic_store(barw + i, 0u, __ATOMIC_RELAXED, __HIP_MEMORY_SCOPE_AGENT);
    __syncthreads();

#ifndef SKIP_P0
    phase0(p, lds, tid, lane, wave, G);
#endif
    gsync(grid);
    const XcdBarrier xbar = xcd_barrier_post(barw, MISC + 8);
#ifndef SKIP_P1
    { pg8::Gemm g{(const bf16*)(p.ws + WS_XN), (const bf16*)(p.ws + WS_WIN), M, 3072, 1024}; pg8::StaticOrder S; S.init(M, 3072, G, (int)blockIdx.x);
      EpiProj E{(bf16*)(p.ws + WS_QK)};
      pg8::gemm_phase<EpiProj, pg8::StaticOrder, true, true>(glds, g, S, E); }
#endif
    xcd_barrier(xbar);
#ifndef SKIP_P2
    phase2(p, lds, tid, lane, wave, G);
#endif
    xcd_barrier(xbar);
    { float* rpbs = (float*)lds; float* wts = (float*)(lds + 16384);
      for (int i = tid; i < 8 * 15 * 31; i += 512) rpbs[i] = p.in[6][i];
      __syncthreads();
#ifndef SKIP_P3A
      const int vcu = (G % 8 == 0) ? (int)(blockIdx.x % 8) * (G / 8) + (int)(blockIdx.x / 8) : (int)blockIdx.x;
      for (int U = vcu; U < 1536; U += G) attn_unit(p, rpbs, (unsigned short*)(lds + 86016 + wave * 2304), U >> 1, (U & 1) * 4 + (wave & 3), (wave >> 2) * 2, lane);
#endif
#ifndef SKIP_P3B
      for (int u = vcu; u < 384 * 8; u += G) s1_unit(p, wts, u, lane, wave);
#endif
    }
    xcd_barrier(xbar);
#ifndef SKIP_P4
    phase_scan(p, tid, G);
#endif
    xcd_barrier(xbar);
#ifndef SKIP_P5
    for (int u = blockIdx.x; u < 768; u += G) s3_unit(p, lds, u, lane, wave);
#endif
    xcd_barrier(xbar);
#ifndef SKIP_P6
    { pg8::Gemm g{(const bf16*)(p.ws + WS_MIX), (const bf16*)(p.ws + WS_WOUT), M, 1024, 1024}; pg8::StaticOrder S; S.init(M, 1024, G, (int)blockIdx.x);
      EpiOut E{p.in[0], p.in[1], p.out, (bf16*)(p.ws + WS_XN), (float*)(p.ws + WS_PART)};
      pg8::gemm_phase<EpiOut, pg8::StaticOrder, true, true>(glds, g, S, E); }
#endif
    xcd_barrier(xbar);
#ifndef SKIP_P7
    { pg8::Gemm g{(const bf16*)(p.ws + WS_XN), (const bf16*)(p.ws + WS_WGU), M, 5632, 1024}; pg8::StaticOrder S; S.init(M, 5632, G, (int)blockIdx.x);
      EpiGU E{(bf16*)(p.ws + WS_HID), (const float*)(p.ws + WS_PART)};
      pg8::gemm_phase<EpiGU, pg8::StaticOrder, true, true>(glds, g, S, E); }
#endif
    xcd_barrier(xbar);
#ifndef SKIP_P8
    { pg8::Gemm g{(const bf16*)(p.ws + WS_HID), (const bf16*)(p.ws + WS_WDN), M, 1024, 2816}; pg8::StaticOrder S; S.init(M, 1024, G, (int)blockIdx.x);
      EpiDown E{p.out};
      pg8::gemm_phase<EpiDown, pg8::StaticOrder, true, true>(glds, g, S, E); }
#endif
}
}

extern "C" void kernel_launch(void* const* d_in, const int* in_sizes, int n_in, void* d_out, int out_size, void* d_ws, size_t ws_size, hipStream_t stream) {
    static int grid = 0;
    if (grid == 0) {
        if (n_in != 20 || out_size != hk::M * 1024 || ws_size < hk::WS_END) { fprintf(stderr, "kernel_launch: unexpected shapes (n_in %d out %d ws %zu)\n", n_in, out_size, ws_size); grid = -1; return; }
        int dev = 0, cus = 0, per_cu = 0;
        if (hipGetDevice(&dev) != hipSuccess || hipDeviceGetAttribute(&cus, hipDeviceAttributeMultiprocessorCount, dev) != hipSuccess) { grid = -1; return; }
        if (hipFuncSetAttribute((const void*)hk::hymba_fwd, hipFuncAttributeMaxDynamicSharedMemorySize, hk::LDS_BYTES) != hipSuccess) { fprintf(stderr, "kernel_launch: hipFuncSetAttribute failed\n"); grid = -1; return; }
        if (hipOccupancyMaxActiveBlocksPerMultiprocessor(&per_cu, (const void*)hk::hymba_fwd, 512, hk::LDS_BYTES) != hipSuccess || per_cu < 1) { fprintf(stderr, "kernel_launch: occupancy query says %d\n", per_cu); (void)hipGetLastError(); grid = -1; return; }
        grid = cus * 1;
    }
    if (grid < 0) return;
    hk::Params prm{};
    for (int i = 0; i < 20; ++i) prm.in[i] = (const float*)d_in[i];
    prm.out = (float*)d_out; prm.ws = (unsigned char*)d_ws;
    void* args[] = {&prm};
    hipError_t e = hipLaunchCooperativeKernel((const void*)hk::hymba_fwd, dim3(grid), dim3(512), args, hk::LDS_BYTES, stream);
    if (e != hipSuccess) fprintf(stderr, "cooperative launch failed: %s (grid %d)\n", hipGetErrorString(e), grid);
}
```

```cpp
#include <hip/hip_runtime.h>
#include <hip/hip_cooperative_groups.h>
#include <cstdio>
#include <cstdint>
namespace cg = cooperative_groups;
namespace pg8 {
#define PG8_LAS __attribute__((address_space(3)))
typedef unsigned short bf16_t;
typedef short bf16x8 __attribute__((ext_vector_type(8)));
typedef float f32x4 __attribute__((ext_vector_type(4)));
typedef unsigned u32x4 __attribute__((ext_vector_type(4)));
constexpr int BM = 256, BK = 64, HALF = 128, HTB = HALF * BK * 2  , STAGE_BYTES = 8 * HTB, NXCD = 8, WGM = 4;

__host__ __device__ __forceinline__ int lds_byte(int r, int c) { const int st = (r >> 4) * 2 + (c >> 5), rr = r & 15, cc = c & 31, ob = rr * 64 + cc * 2; return st * 1024 + (ob ^ (((ob >> 9) & 1) << 5)); }
__host__ __device__ __forceinline__ void stage_rc(int b, int& R, int& C) { const int st = b / 1024, sb = b % 1024, swz = sb ^ (((sb >> 9) & 1) << 5); R = (st >> 1) * 16 + swz / 64; C = (st & 1) * 32 + (swz % 64) / 2; }
__host__ __device__ __forceinline__ int perm32(int rho) { const int n = rho >> 4, i = rho & 15; return 8 * (i >> 2) + 4 * n + (i & 3); }

struct Unit { int pm, pn; };
struct Gemm { const bf16_t* A; const bf16_t* Bt; int M, N, K; };

struct StaticOrder {
    int nM, nN, nwg, G, c;
    __host__ __device__ void init(int M, int N, int G_, int c_) { nM = M / BM; nN = N / BM; nwg = nM * nN; G = G_; c = c_; }
    __host__ __device__ bool next(int i, Unit& u) const {
        const long L = (long)i * G + c; if (L >= nwg) return false;
        int wgid = (int)L; { const int q = nwg / NXCD, r = nwg % NXCD, xcd = wgid % NXCD, off = wgid / NXCD; wgid = (xcd < r ? xcd * (q + 1) : r * (q + 1) + (xcd - r) * q) + off; }
        const int nig = WGM * nN, gid = wgid / nig, fm = gid * WGM, gsz = (nM - fm) < WGM ? (nM - fm) : WGM;
        u.pm = fm + ((wgid % nig) % gsz); u.pn = (wgid % nig) / gsz; return true;
    }
    __device__ __forceinline__ void a_ready(const Unit&) const {}
    __device__ __forceinline__ void done(const Unit&) const {}
};

__device__ __forceinline__ unsigned cvt_pk_bf16(float lo, float hi) { unsigned r; asm volatile("v_cvt_pk_bf16_f32 %0, %1, %2" : "=v"(r) : "v"(lo), "v"(hi)); return r; }
template <class Epi, class Sched, bool ALIGN_EPI = false, bool SP2 = false>
__device__ __forceinline__ void gemm_phase(PG8_LAS unsigned char* lds, const Gemm g, const Sched& S, const Epi& E) {
    const int tid = threadIdx.x, wid = __builtin_amdgcn_readfirstlane(tid >> 6), lane = tid & 63, wr = wid >> 2, wc = wid & 3, fr = lane & 15, fq = lane >> 4;
    const int K = g.K, nt = K / BK;
    unsigned voffA[2], voffB[2];
#pragma unroll
    for (int i = 0; i < 2; ++i) { int R, C; stage_rc(tid * 16 + i * 8192, R, C); const int Rb = Epi::PERM ? ((R & ~31) + perm32(R & 31)) : R;
        voffA[i] = (unsigned)(R * K + C) * 2u; voffB[i] = (unsigned)(Rb * K + C) * 2u; }
    const size_t kstep = (size_t)(BK * 2);
    const size_t hstep = (size_t)HALF * K * 2;
    const size_t tstep = 2 * hstep;
    const unsigned ldsw = (unsigned)wid * 1024u;
    const int aoff = lds_byte(wr * 64 + fr, fq * 8), boff = lds_byte(wc * 32 + fr, fq * 8);
#define PG8_SA(b, h) (((b) * 2 + (h)) * HTB)
#define PG8_SB(b, h) ((4 + (b) * 2 + (h)) * HTB)
#define PG8_STAGE(bufoff, gbase, voff) do { _Pragma("unroll") for (int _i = 0; _i < 2; ++_i) \
        __builtin_amdgcn_global_load_lds((const unsigned*)((const char*)(gbase) + (voff)[_i]), (PG8_LAS unsigned*)(lds + (bufoff) + ldsw + _i * 8192), 16, 0, 0); } while (0)
#define PG8_LDA(dst, b, h) do { _Pragma("unroll") for (int m = 0; m < 4; ++m) _Pragma("unroll") for (int k = 0; k < 2; ++k) dst[m][k] = *(const PG8_LAS bf16x8*)(lds + PG8_SA(b, h) + aoff + m * 2048 + k * 1024); } while (0)
#define PG8_LDB(dst, b, h) do { _Pragma("unroll") for (int n = 0; n < 2; ++n) _Pragma("unroll") for (int k = 0; k < 2; ++k) dst[n][k] = *(const PG8_LAS bf16x8*)(lds + PG8_SB(b, h) + boff + n * 2048 + k * 1024); } while (0)
#define PG8_MMA(ai, bj, At, Bt) do { __builtin_amdgcn_s_setprio(1); _Pragma("unroll") for (int m = 0; m < 4; ++m) _Pragma("unroll") for (int n = 0; n < 2; ++n) _Pragma("unroll") for (int k = 0; k < 2; ++k) \
        acc[ai][bj][m][n] = __builtin_amdgcn_mfma_f32_16x16x32_bf16(Bt[n][k], At[m][k], acc[ai][bj][m][n], 0, 0, 0); __builtin_amdgcn_s_setprio(0); } while (0)
#define PG8_WAIT_V(n) asm volatile("s_waitcnt vmcnt(" #n ")" ::: "memory")
#define PG8_WAIT_L(n) asm volatile("s_waitcnt lgkmcnt(" #n ")" ::: "memory")
#define PG8_BAR __builtin_amdgcn_s_barrier()
#define PG8_SCHED __builtin_amdgcn_sched_barrier(0)
    Unit cur, nxt; int ui = 0;
    if (!S.next(0, cur)) return;
    f32x4 acc[2][2][4][2];
#pragma unroll
    for (int a = 0; a < 2; ++a)
#pragma unroll
        for (int b = 0; b < 2; ++b)
#pragma unroll
            for (int m = 0; m < 4; ++m)
#pragma unroll
                for (int n = 0; n < 2; ++n) acc[a][b][m][n] = (f32x4){0.f, 0.f, 0.f, 0.f};
    bf16x8 At[4][2], B0[2][2], B1[2][2];
    const char* cA = (const char*)g.A + (size_t)cur.pm * tstep; const char* cB = (const char*)g.Bt + (size_t)cur.pn * tstep;
    S.a_ready(cur);
    if constexpr (SP2) {
        PG8_STAGE(PG8_SB(0, 0), cB, voffB); PG8_STAGE(PG8_SB(0, 1), cB + hstep, voffB); PG8_STAGE(PG8_SA(0, 0), cA, voffA); PG8_STAGE(PG8_SA(0, 1), cA + hstep, voffA);
        if (wr == 1) PG8_BAR;
        PG8_WAIT_V(2); PG8_BAR;
        PG8_STAGE(PG8_SB(1, 0), cB + kstep, voffB); PG8_STAGE(PG8_SA(1, 0), cA + kstep, voffA); PG8_STAGE(PG8_SB(1, 1), cB + hstep + kstep, voffB);
        PG8_WAIT_V(6); PG8_BAR;
    } else {
        PG8_STAGE(PG8_SB(0, 0), cB, voffB); PG8_STAGE(PG8_SA(0, 0), cA, voffA); PG8_STAGE(PG8_SB(0, 1), cB + hstep, voffB); PG8_STAGE(PG8_SA(0, 1), cA + hstep, voffA);
        if (wr == 1) PG8_BAR;
        PG8_WAIT_V(4); PG8_BAR;
        PG8_STAGE(PG8_SB(1, 0), cB + kstep, voffB); PG8_STAGE(PG8_SA(1, 0), cA + kstep, voffA); PG8_STAGE(PG8_SB(1, 1), cB + hstep + kstep, voffB);
        PG8_WAIT_V(6); PG8_BAR;
    }
    for (;;) {
        const bool has_next = S.next(ui + 1, nxt);
        const char* nA = has_next ? (const char*)g.A + (size_t)nxt.pm * tstep : cA; const char* nB = has_next ? (const char*)g.Bt + (size_t)nxt.pn * tstep : cB;
        for (int t = 0; t < nt; t += 2) {
            const bool last = (t == nt - 2);
            const char* a1 = cA + (size_t)(t + 1) * kstep;
            const char* a2 = last ? nA : cA + (size_t)(t + 2) * kstep; const char* b2 = last ? nB : cB + (size_t)(t + 2) * kstep;
            const char* a3 = a2 + kstep; const char* b3 = b2 + kstep;
            if (last && has_next) S.a_ready(nxt);
            if constexpr (SP2) {
            PG8_LDB(B0, 0, 0); PG8_LDB(B1, 0, 1); PG8_SCHED; PG8_LDA(At, 0, 0); PG8_STAGE(PG8_SA(1, 1), a1 + hstep, voffA);
            PG8_WAIT_V(8); PG8_WAIT_L(0); PG8_BAR; PG8_MMA(0, 0, At, B0); PG8_MMA(0, 1, At, B1); PG8_BAR; PG8_SCHED;
            PG8_LDA(At, 0, 1); PG8_STAGE(PG8_SB(0, 0), b2, voffB); PG8_STAGE(PG8_SB(0, 1), b2 + hstep, voffB); PG8_STAGE(PG8_SA(0, 0), a2, voffA);
            PG8_WAIT_V(8); PG8_WAIT_L(0); PG8_BAR; PG8_MMA(1, 0, At, B0); PG8_MMA(1, 1, At, B1); PG8_BAR; PG8_SCHED;
            PG8_LDB(B0, 1, 0); PG8_LDB(B1, 1, 1); PG8_SCHED; PG8_LDA(At, 1, 0); PG8_STAGE(PG8_SA(0, 1), a2 + hstep, voffA);
            PG8_WAIT_V(8); PG8_WAIT_L(0); PG8_BAR; PG8_MMA(0, 0, At, B0); PG8_MMA(0, 1, At, B1); PG8_BAR; PG8_SCHED;
            PG8_LDA(At, 1, 1); PG8_STAGE(PG8_SB(1, 0), b3, voffB); PG8_STAGE(PG8_SB(1, 1), b3 + hstep, voffB); PG8_STAGE(PG8_SA(1, 0), a3, voffA);
            PG8_WAIT_V(8); PG8_WAIT_L(0); PG8_BAR; PG8_MMA(1, 0, At, B0); PG8_MMA(1, 1, At, B1); PG8_BAR; PG8_SCHED;
            } else {
            PG8_LDB(B0, 0, 0); PG8_SCHED; PG8_LDA(At, 0, 0); PG8_STAGE(PG8_SA(1, 1), a1 + hstep, voffA);
            PG8_WAIT_L(8); PG8_BAR; PG8_WAIT_L(0); PG8_MMA(0, 0, At, B0); PG8_BAR; PG8_SCHED;
            PG8_LDB(B1, 0, 1); PG8_STAGE(PG8_SB(0, 0), b2, voffB);
            PG8_BAR; PG8_WAIT_L(0); PG8_MMA(0, 1, At, B1); PG8_BAR;
            PG8_LDA(At, 0, 1); PG8_STAGE(PG8_SA(0, 0), a2, voffA);
            PG8_BAR; PG8_WAIT_L(0); PG8_MMA(1, 0, At, B0); PG8_BAR; PG8_SCHED;
            PG8_STAGE(PG8_SB(0, 1), b2 + hstep, voffB);
            PG8_WAIT_V(6); PG8_BAR; PG8_MMA(1, 1, At, B1); PG8_BAR;
            PG8_LDB(B0, 1, 0); PG8_SCHED; PG8_LDA(At, 1, 0); PG8_STAGE(PG8_SA(0, 1), a2 + hstep, voffA);
            PG8_WAIT_L(8); PG8_BAR; PG8_WAIT_L(0); PG8_MMA(0, 0, At, B0); PG8_BAR; PG8_SCHED;
            PG8_LDB(B1, 1, 1); PG8_STAGE(PG8_SB(1, 0), b3, voffB);
            PG8_BAR; PG8_WAIT_L(0); PG8_MMA(0, 1, At, B1); PG8_BAR;
            PG8_LDA(At, 1, 1); PG8_STAGE(PG8_SA(1, 0), a3, voffA);
            PG8_BAR; PG8_WAIT_L(0); PG8_MMA(1, 0, At, B0); PG8_BAR; PG8_SCHED;
            PG8_STAGE(PG8_SB(1, 1), b3 + hstep, voffB);
            PG8_WAIT_V(6); PG8_BAR; PG8_MMA(1, 1, At, B1); PG8_BAR;
            }
        }
        if constexpr (ALIGN_EPI) { if (wr == 0) PG8_BAR; }
        if constexpr (!Epi::AFTER_DRAIN) { E(acc, cur, wr, wc, fr, fq); S.done(cur); }
        if (!has_next) break;
#pragma unroll
        for (int a = 0; a < 2; ++a)
#pragma unroll
            for (int b = 0; b < 2; ++b)
#pragma unroll
                for (int m = 0; m < 4; ++m)
#pragma unroll
                    for (int n = 0; n < 2; ++n) acc[a][b][m][n] = (f32x4){0.f, 0.f, 0.f, 0.f};
        cur = nxt; cA = nA; cB = nB; ++ui;
        if constexpr (ALIGN_EPI) { if (wr == 1) PG8_BAR; }
    }
    PG8_WAIT_V(0);
    if constexpr (!ALIGN_EPI) { if (wr == 0) PG8_BAR; }
    PG8_BAR;
    if constexpr (Epi::AFTER_DRAIN) { E.fused(acc, cur, wr, wc, fr, fq, lds, wid, lane); S.done(cur); }
#undef PG8_SA
#undef PG8_SB
#undef PG8_STAGE
#undef PG8_LDA
#undef PG8_LDB
#undef PG8_MMA
#undef PG8_WAIT_V
#undef PG8_WAIT_L
#undef PG8_BAR
#undef PG8_SCHED
}
}
namespace hk {
typedef unsigned short bf16;
typedef short bf16x8 __attribute__((ext_vector_type(8)));
typedef float f32x4 __attribute__((ext_vector_type(4)));
typedef unsigned u32x4 __attribute__((ext_vector_type(4)));
typedef unsigned u32x2 __attribute__((ext_vector_type(2)));

constexpr int M = 49152, MP = 16384;
constexpr float EPS = 1e-6f;
constexpr size_t MiB = 1u << 20;
constexpr size_t WS_PART = 29 * MiB;
constexpr size_t WS_CDEC = 0;
constexpr size_t WS_BAR = 800 * 1024;
constexpr size_t WS_DT = 1 * MiB;
constexpr size_t WS_WIN = 4 * MiB, WS_WOUT = 10 * MiB, WS_WGU = 12 * MiB, WS_WDN = 23 * MiB;
constexpr size_t WS_XN = 32 * MiB;
constexpr size_t WS_QK = 128 * MiB, WS_VZ = 224 * MiB, WS_XBC = 320 * MiB;
constexpr size_t WS_HID = 128 * MiB;
constexpr size_t WS_MIX = 416 * MiB;
constexpr size_t WS_END = 512 * MiB;
constexpr size_t DO_XT = 0, DO_BROW = 48 * MiB, DO_BT = 72 * MiB, DO_CROW = 96 * MiB, DO_VT = 120 * MiB;

struct Params { const float* in[20]; float* out; unsigned char* ws; };

__device__ __forceinline__ float bf2f(unsigned v) { return __uint_as_float(v << 16); }
typedef float f32x2_t __attribute__((ext_vector_type(2))); typedef __bf16 bf16x2_t __attribute__((ext_vector_type(2)));
__device__ __forceinline__ unsigned pk2c(float lo, float hi) { f32x2_t v = {lo, hi}; bf16x2_t b = __builtin_convertvector(v, bf16x2_t); return __builtin_bit_cast(unsigned, b); }
__device__ __forceinline__ unsigned pk2(float lo, float hi) { return pg8::cvt_pk_bf16(lo, hi); }
__device__ __forceinline__ unsigned short f2bf(float f) { return (unsigned short)(pk2(f, 0.f) & 0xffffu); }
__device__ __forceinline__ f32x4 mfma16(bf16x8 a, bf16x8 b, f32x4 c) { return __builtin_amdgcn_mfma_f32_16x16x32_bf16(a, b, c, 0, 0, 0); }
__device__ __forceinline__ float wave_sum(float v) {
#pragma unroll
    for (int o = 1; o < 64; o <<= 1) v += __shfl_xor(v, o);
    return v;
}
__device__ __forceinline__ float silu(float x) { return x * __builtin_amdgcn_rcpf(1.f + __expf(-x)); }
__device__ __forceinline__ bf16x8 pack8(const float (&f)[8]) {
    u32x4 w; w.x = pk2(f[0], f[1]); w.y = pk2(f[2], f[3]); w.z = pk2(f[4], f[5]); w.w = pk2(f[6], f[7]);
    return __builtin_bit_cast(bf16x8, w);
}
__device__ __forceinline__ bf16x8 pack8m(const float (&f)[8]) {
    u32x4 w; w.x = pk2c(f[0], f[1]); w.y = pk2c(f[2], f[3]); w.z = pk2c(f[4], f[5]); w.w = pk2c(f[6], f[7]);
    return __builtin_bit_cast(bf16x8, w);
}
#define LDS_WAIT() asm volatile("s_waitcnt lgkmcnt(0)" ::: "memory")
__device__ __forceinline__ void mfma_operand_pad(bf16x8& f) { asm volatile("s_nop 7" : "+v"(f)); }

__device__ __forceinline__ void wave_scan2(float a0, float a1, int lane, float& p0, float& p1, float& tot) {
    const float s = a0 + a1; float inc = s;
#pragma unroll
    for (int o = 1; o < 64; o <<= 1) { const float t = __shfl_up(inc, o); if (lane >= o) inc += t; }
    const float excl = inc - s;
    p0 = excl + a0; p1 = p0 + a1; tot = __shfl(inc, 63);
}

__device__ __forceinline__ void tr_item(const float* __restrict__ W, int ldw, int K, int col0, bf16* WT, int dstrow0, const float* __restrict__ kscale, float* scr, int k0, int lane) {
#pragma unroll 8
    for (int i = 0; i < 32; ++i) { const int kk = 2 * i + (lane >> 5); scr[kk * 33 + (lane & 31)] = W[(size_t)(k0 + kk) * ldw + col0 + (lane & 31)]; }
    LDS_WAIT();
    const int c = lane & 7;
    float ks[8];
#pragma unroll
    for (int i = 0; i < 8; ++i) ks[i] = kscale ? kscale[k0 + 8 * c + i] : 1.f;
#pragma unroll
    for (int j = 0; j < 4; ++j) { const int n = (lane >> 3) + 8 * j; const float* s = scr + (8 * c) * 33 + n;
        u32x4 o; o.x = pk2(s[0 * 33] * ks[0], s[1 * 33] * ks[1]); o.y = pk2(s[2 * 33] * ks[2], s[3 * 33] * ks[3]);
        o.z = pk2(s[4 * 33] * ks[4], s[5 * 33] * ks[5]); o.w = pk2(s[6 * 33] * ks[6], s[7 * 33] * ks[7]);
        *(u32x4*)(WT + (size_t)(dstrow0 + n) * K + k0 + 8 * c) = o; }
    LDS_WAIT();
}

__device__ __forceinline__ void phase0(const Params& p, unsigned char* lds, int tid, int lane, int wave, int G) {
    const int gw = blockIdx.x * 8 + wave, NGW = G * 8;
    float* scr = (float*)(lds + 65536 + wave * 8448);
    const float* norm1_w = p.in[2]; const float* w_in = p.in[3]; const float* w_out = p.in[15]; const float* norm2_w = p.in[16];
    const float* w_gate = p.in[17]; const float* w_up = p.in[18]; const float* w_down = p.in[19];
    bf16* Win_t = (bf16*)(p.ws + WS_WIN); bf16* Wout_t = (bf16*)(p.ws + WS_WOUT); bf16* Wgu_t = (bf16*)(p.ws + WS_WGU); bf16* Wdn_t = (bf16*)(p.ws + WS_WDN);
    constexpr int I_IN = 16 * 96, I_OUT = 16 * 32, I_G = 16 * 88, I_DN = 44 * 32, NIT = I_IN + I_OUT + 2 * I_G + I_DN;
    for (int it = gw; it < NIT; it += NGW) {
        int r = it;
        if (r < I_IN) { const int kb = r / 96, nb = r % 96; tr_item(w_in, 3088, 1024, nb * 32, Win_t, nb * 32, norm1_w, scr, kb * 64, lane); continue; } r -= I_IN;
        if (r < I_OUT) { const int kb = r / 32, nb = r % 32; tr_item(w_out, 1024, 1024, nb * 32, Wout_t, nb * 32, nullptr, scr, kb * 64, lane); continue; } r -= I_OUT;
        if (r < I_G) { const int kb = r / 88, nb = r % 88, c0 = nb * 32; tr_item(w_gate, 2816, 1024, c0, Wgu_t, (c0 >> 7) * 256 + (c0 & 127), norm2_w, scr, kb * 64, lane); continue; } r -= I_G;
        if (r < I_G) { const int kb = r / 88, nb = r % 88, c0 = nb * 32; tr_item(w_up, 2816, 1024, c0, Wgu_t, (c0 >> 7) * 256 + 128 + (c0 & 127), norm2_w, scr, kb * 64, lane); continue; } r -= I_G;
        { const int kb = r / 32, nb = r % 32; tr_item(w_down, 1024, 2816, nb * 32, Wdn_t, nb * 32, nullptr, scr, kb * 64, lane); }
    }
    float* wdt = (float*)lds;
    for (int idx = tid; idx < 16384; idx += 512) { const int col = idx >> 4, o = idx & 15; wdt[o * 1024 + col] = w_in[(size_t)col * 3088 + 3072 + o] * norm1_w[col]; }
    __syncthreads();
    const float* xp = p.in[0]; const float* xs = p.in[1]; const float* dtbf = p.in[9]; const float* dtbb = p.in[10];
    bf16* XN = (bf16*)(p.ws + WS_XN); float* DT = (float*)(p.ws + WS_DT);
    f32x4 vn[4];
    { const float* xr = gw < MP ? xp + (size_t)gw * 1024 : xs + (size_t)(gw - MP) * 1024;
#pragma unroll
        for (int j = 0; j < 4; ++j) vn[j] = ((const f32x4*)xr)[64 * j + lane]; }
    const int oidx = ((lane >> 5) & 1) * 8 + ((lane >> 4) & 1) * 4 + ((lane >> 3) & 1) * 2 + ((lane >> 2) & 1);
    const float obias = oidx < 8 ? dtbf[oidx] : dtbb[oidx - 8];
    for (int row = gw; row < M; row += NGW) {
        f32x4 v[4]; float ss = 0.f;
#pragma unroll
        for (int j = 0; j < 4; ++j) { v[j] = vn[j]; ss += (v[j].x * v[j].x + v[j].y * v[j].y) + (v[j].z * v[j].z + v[j].w * v[j].w); }
        { const int nrow = row + NGW;
            if (nrow < M) { const float* xr = nrow < MP ? xp + (size_t)nrow * 1024 : xs + (size_t)(nrow - MP) * 1024;
#pragma unroll
                for (int j = 0; j < 4; ++j) vn[j] = ((const f32x4*)xr)[64 * j + lane]; } }
        const float rstd = rsqrtf(wave_sum(ss) * (1.f / 1024.f) + EPS);
#pragma unroll
        for (int j = 0; j < 4; ++j) { v[j] = v[j] * rstd; u32x2 o; o.x = pk2(v[j].x, v[j].y); o.y = pk2(v[j].z, v[j].w); ((u32x2*)(XN + (size_t)row * 1024))[64 * j + lane] = o; }
        float part[16];
#pragma unroll
        for (int o = 0; o < 16; ++o) { float acc = 0.f;
#pragma unroll
            for (int j = 0; j < 4; ++j) { const f32x4 w = *(const f32x4*)(wdt + o * 1024 + 256 * j + 4 * lane); acc += (v[j].x * w.x + v[j].y * w.y) + (v[j].z * w.z + v[j].w * w.w); }
            part[o] = acc; }
        float r8[8], r4[4], r2[2];
#pragma unroll
        for (int o = 0; o < 8; ++o) { const bool hi = (lane & 32) != 0; const float send = hi ? part[o] : part[o + 8], keep = hi ? part[o + 8] : part[o]; r8[o] = keep + __shfl_xor(send, 32); }
#pragma unroll
        for (int o = 0; o < 4; ++o) { const bool hi = (lane & 16) != 0; const float send = hi ? r8[o] : r8[o + 4], keep = hi ? r8[o + 4] : r8[o]; r4[o] = keep + __shfl_xor(send, 16); }
#pragma unroll
        for (int o = 0; o < 2; ++o) { const bool hi = (lane & 8) != 0; const float send = hi ? r4[o] : r4[o + 2], keep = hi ? r4[o + 2] : r4[o]; r2[o] = keep + __shfl_xor(send, 8); }
        float r1; { const bool hi = (lane & 4) != 0; const float send = hi ? r2[0] : r2[1], keep = hi ? r2[1] : r2[0]; r1 = keep + __shfl_xor(send, 4); }
        r1 += __shfl_xor(r1, 1); r1 += __shfl_xor(r1, 2);
        if ((lane & 3) == 0) { const float x = r1 + obias; DT[(size_t)row * 16 + oidx] = fmaxf(x, 0.f) + log1pf(__expf(-fabsf(x))); }
    }
}

__device__ __forceinline__ void conv_load(const Params& p, int u, int tid, bf16x8 (&pre)[3], float& wpre) {
    const int c = u >> 4, sb = u & 15, t0 = c * 128;
    wpre = 0.f; if (tid < 320) wpre = p.in[7][(tid >> 6) * 1024 + sb * 64 + (tid & 63)]; else if (tid < 384) wpre = p.in[8][sb * 64 + (tid - 320)];
    const bool first = (c < 128) ? ((c & 63) == 0) : (((c - 128) & 15) == 0);
    const bool last = (c < 128) ? ((c & 63) == 63) : (((c - 128) & 15) == 15);
    const bf16* XBC = (const bf16*)(p.ws + WS_XBC);
#pragma unroll
    for (int k = 0; k < 3; ++k) { const int idx = tid + 512 * k; const int rr = idx >> 3, seg = idx & 7; const int t = t0 - 2 + rr;
        const bool ok = (idx < 132 * 8) && (rr >= 2 || !first) && (rr < 130 || !last);
        bf16x8 v = {0, 0, 0, 0, 0, 0, 0, 0}; if (ok) v = *(const bf16x8*)(XBC + (size_t)t * 1024 + sb * 64 + seg * 8);
        pre[k] = v; }
}
__device__ __forceinline__ void conv_unit(const Params& p, unsigned char* lds, int u, int unext, int tid, bf16x8 (&pre)[3], float& wpre) {
    const int c = u >> 4, sb = u & 15, t0 = c * 128;
    float* raw = (float*)lds;
#pragma unroll
    for (int k = 0; k < 3; ++k) { const int idx = tid + 512 * k; const int rr = idx >> 3, seg = idx & 7;
        if (idx < 132 * 8) {
#pragma unroll
            for (int j = 0; j < 8; ++j) raw[rr * 65 + seg * 8 + j] = bf2f((unsigned short)pre[k][j]); } }
    float* wl = raw + 132 * 65;
    if (tid < 384) wl[tid] = wpre;
    __syncthreads();
    if (unext < 384 * 16) conv_load(p, unext, tid, pre, wpre);
    unsigned char* dout = (unsigned char*)p.out;
    {
        const int ch = tid & 63, l0 = (tid >> 6) * 16;
        const float w0 = wl[ch], w1 = wl[64 + ch], w2 = wl[128 + ch], w3 = wl[192 + ch], w4 = wl[256 + ch], b = wl[320 + ch];
        float rv[20];
#pragma unroll
        for (int k = 0; k < 20; ++k) rv[k] = raw[(l0 + k) * 65 + ch];
        float ov[16];
#pragma unroll
        for (int j = 0; j < 16; ++j) ov[j] = silu(b + rv[j] * w0 + rv[j + 1] * w1 + rv[j + 2] * w2 + rv[j + 3] * w3 + rv[j + 4] * w4);
        if (sb >= 8) {
            bf16* dst = ((sb < 12) ? (bf16*)(dout + DO_BROW) + (sb - 8) * 64 + ch : (bf16*)(dout + DO_CROW) + (sb - 12) * 64 + ch) + (size_t)(t0 + l0) * 256;
#pragma unroll
            for (int j = 0; j < 16; ++j) dst[(size_t)j * 256] = f2bf(ov[j]);
        }
        if (sb < 12) {
            bf16* dstT = ((sb < 8) ? (bf16*)(dout + DO_XT) + (size_t)(c * 8 + sb) * 8192 + ch * 128
                                   : (bf16*)(dout + DO_BT) + ((size_t)(c * 2 + ((sb - 8) >> 1)) * 128 + ((sb - 8) & 1) * 64 + ch) * 128) + l0;
            u32x4 o0, o1;
            o0.x = pk2(ov[0], ov[1]); o0.y = pk2(ov[2], ov[3]); o0.z = pk2(ov[4], ov[5]); o0.w = pk2(ov[6], ov[7]);
            o1.x = pk2(ov[8], ov[9]); o1.y = pk2(ov[10], ov[11]); o1.z = pk2(ov[12], ov[13]); o1.w = pk2(ov[14], ov[15]);
            *(u32x4*)dstT = o0; *(u32x4*)(dstT + 8) = o1;
        }
    }
    __syncthreads();
}

__device__ __forceinline__ void phase2(const Params& p, unsigned char* lds, int tid, int lane, int wave, int G) {
    { bf16x8 pre[3]; float wpre; conv_load(p, blockIdx.x, tid, pre, wpre);
      for (int u = blockIdx.x; u < 384 * 16; u += G) conv_unit(p, lds, u, u + G, tid, pre, wpre); }
    const int gw = blockIdx.x * 8 + wave, NGW = G * 8;
    bf16* QK = (bf16*)(p.ws + WS_QK); const float* qw = p.in[4]; const float* kw = p.in[5];
    for (int row0 = gw; row0 < M; row0 += 4 * NGW) {
        bf16x8 vv[4][2];
#pragma unroll
        for (int r = 0; r < 4; ++r)
#pragma unroll
            for (int pass = 0; pass < 2; ++pass) { const int row = row0 + r * NGW; if (row < M) vv[r][pass] = *(const bf16x8*)(QK + (size_t)row * 1024 + pass * 512 + lane * 8); }
#pragma unroll
        for (int r = 0; r < 4; ++r)
#pragma unroll
            for (int pass = 0; pass < 2; ++pass) { const int row = row0 + r * NGW; if (row >= M) continue;
                float f[8]; float ss = 0.f;
#pragma unroll
                for (int j = 0; j < 8; ++j) { f[j] = bf2f((unsigned short)vv[r][pass][j]); ss += f[j] * f[j]; }
                ss += __shfl_xor(ss, 1); ss += __shfl_xor(ss, 2); ss += __shfl_xor(ss, 4);
                const float rstd = rsqrtf(ss * (1.f / 64.f) + EPS) * (pass == 0 ? 0.125f : 1.f);
                const float* w = (pass ? kw : qw) + (lane & 7) * 8;
#pragma unroll
                for (int j = 0; j < 8; ++j) f[j] = f[j] * rstd * w[j];
                *(bf16x8*)(QK + (size_t)row * 1024 + pass * 512 + lane * 8) = pack8(f); }
    }
    const bf16* VZ = (const bf16*)(p.ws + WS_VZ); bf16* VT = (bf16*)((unsigned char*)p.out + DO_VT);
    unsigned short* scr = (unsigned short*)(lds + 65536 + wave * 8448);
    for (int it = gw; it < 768 * 8; it += NGW) { const int R = it >> 3, h = it & 7;
        const bf16* src = VZ + (size_t)(R * 64 + lane) * 1024 + h * 64;
#pragma unroll
        for (int seg = 0; seg < 8; ++seg) { const bf16x8 v = *(const bf16x8*)(src + seg * 8);
#pragma unroll
            for (int j = 0; j < 8; ++j) scr[lane * 66 + seg * 8 + j] = (unsigned short)v[j]; }
        LDS_WAIT();
#pragma unroll
        for (int seg = 0; seg < 8; ++seg) { u32x4 o;
            o.x = (unsigned)scr[(seg * 8 + 0) * 66 + lane] | ((unsigned)scr[(seg * 8 + 1) * 66 + lane] << 16);
            o.y = (unsigned)scr[(seg * 8 + 2) * 66 + lane] | ((unsigned)scr[(seg * 8 + 3) * 66 + lane] << 16);
            o.z = (unsigned)scr[(seg * 8 + 4) * 66 + lane] | ((unsigned)scr[(seg * 8 + 5) * 66 + lane] << 16);
            o.w = (unsigned)scr[(seg * 8 + 6) * 66 + lane] | ((unsigned)scr[(seg * 8 + 7) * 66 + lane] << 16);
            *(u32x4*)(VT + ((size_t)it * 64 + lane) * 64 + seg * 8) = o; }
        LDS_WAIT();
    }
}
__device__ __forceinline__ void attn_unit(const Params& p, const float* rpbs, unsigned short* ost, int R, int h, int qbs, int lane) {
    const bf16* QK = (const bf16*)(p.ws + WS_QK); const bf16* VT = (const bf16*)((const unsigned char*)p.out + DO_VT); bf16* MIX = (bf16*)(p.ws + WS_MIX);
    int r, rows; if (R < 256) { r = R & 127; rows = 128; } else { r = (R - 256) & 31; rows = 32; }
    const int Rb = R - r;
    int r0 = r - 4; r0 = r0 < 0 ? 0 : r0; r0 = r0 > rows - 8 ? rows - 8 : r0;
    const int fr = lane & 15, quad = lane >> 4;
    for (int qb = qbs; qb < qbs + 2; ++qb) {
        const int kc0 = (qb == 0) ? 0 : (qb == 1 ? 8 : (qb == 2 ? 24 : 32));
        const int qc = qb * 16 + fr;
        const bf16* qp = QK + (size_t)(R * 64 + qc) * 1024 + h * 64 + quad * 8;
        bf16x8 qf0 = *(const bf16x8*)qp, qf1 = *(const bf16x8*)(qp + 32); mfma_operand_pad(qf0); mfma_operand_pad(qf1);
        f32x4 st[8][2];
#pragma unroll
        for (int i = 0; i < 8; ++i)
#pragma unroll
            for (int t = 0; t < 2; ++t) { const int kcm = kc0 + (fr >> 2) * 8 + 4 * t + (fr & 3);
                const bf16* kp = QK + (size_t)((Rb + r0 + i) * 64 + kcm) * 1024 + 512 + h * 64 + quad * 8;
                bf16x8 k0 = *(const bf16x8*)kp, k1 = *(const bf16x8*)(kp + 32); mfma_operand_pad(k0); mfma_operand_pad(k1);
                f32x4 a = {0.f, 0.f, 0.f, 0.f}; a = mfma16(k0, qf0, a); a = mfma16(k1, qf1, a); st[i][t] = a; }
        int c0q = qc - 8; c0q = c0q < 0 ? 0 : c0q; c0q = c0q > 48 ? 48 : c0q;
        float mx = -1e30f;
#pragma unroll
        for (int i = 0; i < 8; ++i)
#pragma unroll
            for (int t = 0; t < 2; ++t)
#pragma unroll
                for (int e = 0; e < 4; ++e) { const int kc = kc0 + quad * 8 + 4 * t + e; const bool valid = (kc >= c0q) && (kc < c0q + 16);
                    int dc = kc - qc + 15; dc = dc < 0 ? 0 : dc; dc = dc > 30 ? 30 : dc;
                    const float bv = rpbs[(h * 15 + (r0 + i - r + 7)) * 31 + dc];
                    float s = st[i][t][e] + bv; s = valid ? s : -1e30f; st[i][t][e] = s; mx = fmaxf(mx, s); }
        mx = fmaxf(mx, __shfl_xor(mx, 16)); mx = fmaxf(mx, __shfl_xor(mx, 32));
        float sum = 0.f;
#pragma unroll
        for (int i = 0; i < 8; ++i)
#pragma unroll
            for (int t = 0; t < 2; ++t)
#pragma unroll
                for (int e = 0; e < 4; ++e) { const float pe = __expf(st[i][t][e] - mx); st[i][t][e] = pe; sum += pe; }
        sum += __shfl_xor(sum, 16); sum += __shfl_xor(sum, 32);
        const float inv = 1.f / sum;
        f32x4 o[4];
#pragma unroll
        for (int dt = 0; dt < 4; ++dt) o[dt] = (f32x4){0.f, 0.f, 0.f, 0.f};
#pragma unroll
        for (int i = 0; i < 8; ++i) {
            float pv[8];
#pragma unroll
            for (int e = 0; e < 4; ++e) { pv[e] = st[i][0][e] * inv; pv[4 + e] = st[i][1][e] * inv; }
            bf16x8 pf = pack8(pv); mfma_operand_pad(pf);
#pragma unroll
            for (int dt = 0; dt < 4; ++dt) { const bf16* vp = VT + ((size_t)((Rb + r0 + i) * 8 + h) * 64 + dt * 16 + fr) * 64 + kc0 + quad * 8;
                bf16x8 vf = *(const bf16x8*)vp; mfma_operand_pad(vf); o[dt] = mfma16(pf, vf, o[dt]); }
        }
#pragma unroll
        for (int dt = 0; dt < 4; ++dt)
#pragma unroll
            for (int e = 0; e < 4; ++e) ost[(quad * 4 + e) * 72 + dt * 16 + fr] = f2bf(o[dt][e]);
        LDS_WAIT();
#pragma unroll
        for (int k = 0; k < 2; ++k) { const int row = k * 8 + (lane >> 3), ch = lane & 7;
            *(u32x4*)(MIX + (size_t)(R * 64 + qb * 16 + row) * 1024 + h * 64 + ch * 8) = *(const u32x4*)(ost + row * 72 + ch * 8); }
        LDS_WAIT();
    }
}

__device__ __forceinline__ void s1_unit(const Params& p, float* wts, int u, int lane, int wave) {
    const int c = u >> 3, h = u & 7, g = h >> 2, t0 = c * 128;
    const float* DT = (const float*)(p.ws + WS_DT); float* CDEC = (float*)(p.ws + WS_CDEC);
    if (wave < 2) { const int dir = wave;
        const float A = -__expf(dir ? p.in[12][h] : p.in[11][h]);
        const float d0 = DT[(size_t)(t0 + 2 * lane) * 16 + dir * 8 + h], d1 = DT[(size_t)(t0 + 2 * lane + 1) * 16 + dir * 8 + h];
        const float a0 = d0 * A, a1 = d1 * A; float p0, p1, tot; wave_scan2(a0, a1, lane, p0, p1, tot);
        float w0, w1;
        if (dir == 0) { w0 = __expf(tot - p0) * d0; w1 = __expf(tot - p1) * d1; }
        else { w0 = __expf(p0 - a0) * d0; w1 = __expf(p1 - a1) * d1; }
        wts[dir * 128 + 2 * lane] = w0; wts[dir * 128 + 2 * lane + 1] = w1;
        if (lane == 0) CDEC[((dir * 384 + c) * 8 + h) * 32] = __expf(tot);
    }
    PG8_LAS unsigned char* xtl = (PG8_LAS unsigned char*)(wts + 4096) + 2 * 64 * 136 * 2 + 2048;
    { const bf16* xsrc = (const bf16*)((const unsigned char*)p.out + DO_XT) + (size_t)(c * 8 + h) * 8192;
#pragma unroll
        for (int k = 0; k < 2; ++k) { const int q = wave * 2 + k, row = q * 4 + (lane >> 4);
            __builtin_amdgcn_global_load_lds((const unsigned*)(xsrc + row * 128 + (((lane & 15) ^ (row & 15)) * 8)), (PG8_LAS unsigned*)(xtl + q * 1024), 16, 0, 0); }
        asm volatile("s_waitcnt vmcnt(0)" ::: "memory"); }
    __syncthreads();
    const int fr = lane & 15, quad = lane >> 4;
    const bf16* XT = (const bf16*)((const unsigned char*)p.out + DO_XT); const bf16* BT = (const bf16*)((const unsigned char*)p.out + DO_BT);
    bf16* STATE = (bf16*)(p.ws + WS_XN);
    f32x4 acc[2][4];
#pragma unroll
    for (int d = 0; d < 2; ++d)
#pragma unroll
        for (int pt = 0; pt < 4; ++pt) acc[d][pt] = (f32x4){0.f, 0.f, 0.f, 0.f};
#pragma unroll
    for (int ks = 0; ks < 4; ++ks) {
        bf16x8 bfr = *(const bf16x8*)(BT + ((size_t)(c * 2 + g) * 128 + wave * 16 + fr) * 128 + ks * 32 + quad * 8); mfma_operand_pad(bfr);
        const f32x4 wf0 = *(const f32x4*)(wts + ks * 32 + quad * 8), wf1 = *(const f32x4*)(wts + ks * 32 + quad * 8 + 4);
        const f32x4 wb0 = *(const f32x4*)(wts + 128 + ks * 32 + quad * 8), wb1 = *(const f32x4*)(wts + 128 + ks * 32 + quad * 8 + 4);
#pragma unroll
        for (int pt = 0; pt < 4; ++pt) {
            const bf16x8 xf = *(const PG8_LAS bf16x8*)(xtl + (pt * 16 + fr) * 256 + (((ks * 4 + quad) ^ fr) * 16));
            float xv[8], sf[8], sb[8];
#pragma unroll
            for (int j = 0; j < 8; ++j) xv[j] = bf2f((unsigned short)xf[j]);
#pragma unroll
            for (int j = 0; j < 4; ++j) { sf[j] = xv[j] * wf0[j]; sf[4 + j] = xv[4 + j] * wf1[j]; sb[j] = xv[j] * wb0[j]; sb[4 + j] = xv[4 + j] * wb1[j]; }
            bf16x8 af = pack8(sf), ab = pack8(sb); mfma_operand_pad(af); mfma_operand_pad(ab);
            acc[0][pt] = mfma16(af, bfr, acc[0][pt]);
            acc[1][pt] = mfma16(ab, bfr, acc[1][pt]);
        }
    }
    unsigned short* stg = (unsigned short*)(wts + 4096);
#pragma unroll
    for (int d = 0; d < 2; ++d)
#pragma unroll
        for (int pt = 0; pt < 4; ++pt)
#pragma unroll
            for (int e = 0; e < 4; ++e) stg[(d * 64 + pt * 16 + quad * 4 + e) * 136 + wave * 16 + fr] = f2bf(acc[d][pt][e]);
    __syncthreads();
    { const int tid = wave * 64 + lane;
#pragma unroll
        for (int i = 0; i < 4; ++i) { const int piece = tid + 512 * i, row = piece >> 4, seg = piece & 15, d = row >> 6, pr = row & 63;
            const u32x4 v = *(const u32x4*)(stg + row * 136 + seg * 8);
            *(u32x4*)(STATE + ((((size_t)d * 384 + c) * 8 + h) * 64 + pr) * 128 + seg * 8) = v; } }
    __syncthreads();
}

__device__ __forceinline__ void phase_scan(const Params& p, int tid, int G) {
    bf16* STATE = (bf16*)(p.ws + WS_XN); const float* CDEC = (const float*)(p.ws + WS_CDEC);
    for (int gt = blockIdx.x * 512 + tid; gt < 131072; gt += G * 512) {
        if (gt < 65536) {
            const int e4 = gt & 2047, h = (gt >> 11) & 7, sd = gt >> 14, sq = sd & 1, dir = sd >> 1, c0 = sq * 64;
            const int cstep = dir ? -1 : 1, cfirst = dir ? c0 + 63 : c0;
            u32x2* base = (u32x2*)(STATE + ((size_t)dir * 384 * 8 + h) * 8192 + e4 * 4);
            const float* dbase = CDEC + (dir * 384 * 8 + h) * 32;
            float hs[4] = {0.f, 0.f, 0.f, 0.f};
            u32x2 qv[8]; float qd[8];
#pragma unroll
            for (int j = 0; j < 8; ++j) { const int c = cfirst + cstep * j; qv[j] = base[(size_t)c * 16384]; qd[j] = dbase[c * 256]; }
#pragma unroll 1
            for (int s0 = 0; s0 < 64; s0 += 8) {
#pragma unroll
                for (int j = 0; j < 8; ++j) { const int c = cfirst + cstep * (s0 + j);
                    const u32x2 v = qv[j]; const float dec = qd[j];
                    if (s0 + 8 < 64) { const int cn = c + cstep * 8; qv[j] = base[(size_t)cn * 16384]; qd[j] = dbase[cn * 256]; }
                    u32x2 o; o.x = pk2(hs[0], hs[1]); o.y = pk2(hs[2], hs[3]); base[(size_t)c * 16384] = o;
                    hs[0] = hs[0] * dec + bf2f(v.x & 0xffffu); hs[1] = hs[1] * dec + bf2f(v.x >> 16); hs[2] = hs[2] * dec + bf2f(v.y & 0xffffu); hs[3] = hs[3] * dec + bf2f(v.y >> 16); }
            }
        } else {
            const int k = gt - 65536;
            float hs[4][8];
#pragma unroll
            for (int j = 0; j < 4; ++j)
#pragma unroll
                for (int i = 0; i < 8; ++i) hs[j][i] = 0.f;
            bf16* cb[4]; const float* db[4]; int cstep[4];
#pragma unroll
            for (int j = 0; j < 4; ++j) { const int it = k + 65536 * j, e8 = it & 1023, h = (it >> 10) & 7, sd = it >> 13, dir = sd >> 4, c0 = 128 + (sd & 15) * 16;
                const int cf = dir ? c0 + 15 : c0; cstep[j] = dir ? -1 : 1;
                cb[j] = STATE + (((size_t)dir * 384 + cf) * 8 + h) * 8192 + e8 * 8; db[j] = CDEC + ((dir * 384 + cf) * 8 + h) * 32; }
            bf16x8 qv[2][4]; float qd[2][4];
#pragma unroll
            for (int d = 0; d < 2; ++d)
#pragma unroll
                for (int j = 0; j < 4; ++j) { qv[d][j] = *(const bf16x8*)(cb[j] + (ptrdiff_t)cstep[j] * d * 65536); qd[d][j] = db[j][cstep[j] * d * 256]; }
#pragma unroll 1
            for (int s0 = 0; s0 < 16; s0 += 2) {
#pragma unroll
                for (int d = 0; d < 2; ++d)
#pragma unroll
                    for (int j = 0; j < 4; ++j) { const int st = s0 + d;
                        const bf16x8 v = qv[d][j]; const float dec = qd[d][j];
                        if (s0 + 2 < 16) { qv[d][j] = *(const bf16x8*)(cb[j] + (ptrdiff_t)cstep[j] * (st + 2) * 65536); qd[d][j] = db[j][cstep[j] * (st + 2) * 256]; }
                        *(bf16x8*)(cb[j] + (ptrdiff_t)cstep[j] * st * 65536) = pack8(hs[j]);
#pragma unroll
                        for (int i = 0; i < 8; ++i) hs[j][i] = hs[j][i] * dec + bf2f((unsigned short)v[i]); }
            }
        }
    }
}

__device__ __forceinline__ void s3_unit(const Params& p, unsigned char* lds, int u, int lane, int wave) {
    const int c = u >> 1, g = u & 1, t0 = c * 128;
    float* acsf = (float*)lds; float* rcsb = acsf + 512; float* dtf = acsf + 1024; float* dtb = acsf + 1536;
    const float* DT = (const float*)(p.ws + WS_DT);
    { const int hl = wave & 3, dir = wave >> 2, h = g * 4 + hl;
        const float A = -__expf(dir ? p.in[12][h] : p.in[11][h]);
        const float d0 = DT[(size_t)(t0 + 2 * lane) * 16 + dir * 8 + h], d1 = DT[(size_t)(t0 + 2 * lane + 1) * 16 + dir * 8 + h];
        const float a0 = d0 * A, a1 = d1 * A; float p0, p1, tot; wave_scan2(a0, a1, lane, p0, p1, tot);
        if (dir == 0) { acsf[hl * 128 + 2 * lane] = p0; acsf[hl * 128 + 2 * lane + 1] = p1; dtf[hl * 128 + 2 * lane] = d0; dtf[hl * 128 + 2 * lane + 1] = d1; }
        else { rcsb[hl * 128 + 2 * lane] = tot - p0 + a0; rcsb[hl * 128 + 2 * lane + 1] = tot - p1 + a1; dtb[hl * 128 + 2 * lane] = d0; dtb[hl * 128 + 2 * lane + 1] = d1; }
    }
    __syncthreads();
    const int fr = lane & 15, quad = lane >> 4, lrow = 16 * wave + fr, l4 = 16 * wave + quad * 4;
    const unsigned char* dout = (const unsigned char*)p.out;
    const bf16* XT = (const bf16*)(dout + DO_XT); const bf16* BROW = (const bf16*)(dout + DO_BROW); const bf16* CROW = (const bf16*)(dout + DO_CROW);
    const bf16* STATE = (const bf16*)(p.ws + WS_XN); const bf16* VZ = (const bf16*)(p.ws + WS_VZ); bf16* MIX = (bf16*)(p.ws + WS_MIX);
    bf16x8 cf[4];
#pragma unroll
    for (int ks = 0; ks < 4; ++ks) { cf[ks] = *(const bf16x8*)(CROW + (size_t)(t0 + lrow) * 256 + g * 128 + ks * 32 + quad * 8); mfma_operand_pad(cf[ks]); }
    PG8_LAS unsigned char* tlb = (PG8_LAS unsigned char*)lds + 74240;
#pragma unroll
    for (int k = 0; k < 4; ++k) { const int q = wave * 4 + k, row = q * 4 + (lane >> 4);
        __builtin_amdgcn_global_load_lds((const unsigned*)(BROW + (size_t)(t0 + row) * 256 + g * 128 + (((lane & 15) ^ (row & 15)) * 8)), (PG8_LAS unsigned*)(tlb + q * 1024), 16, 0, 0); }
    asm volatile("s_waitcnt vmcnt(0)" ::: "memory");
    __syncthreads();
    f32x4 cb[4][2];
#pragma unroll
    for (int sp = 0; sp < 4; ++sp)
#pragma unroll
        for (int t = 0; t < 2; ++t) { const int srow = sp * 32 + (fr >> 2) * 8 + 4 * t + (fr & 3);
            f32x4 a = {0.f, 0.f, 0.f, 0.f};
#pragma unroll
            for (int ks = 0; ks < 4; ++ks) a = mfma16(*(const PG8_LAS bf16x8*)(tlb + srow * 256 + (((ks * 4 + quad) ^ (srow & 15)) * 16)), cf[ks], a);
            cb[sp][t] = a; }
    float ssq[4] = {0.f, 0.f, 0.f, 0.f};
    unsigned short* gsm = (unsigned short*)(lds + 8192 + wave * 8192);
    float* rsm = (float*)(lds + 8192 + 8 * 8192) + wave * 16;
    PG8_LAS unsigned char* tl = (PG8_LAS unsigned char*)lds + 74240;
    const int dj = lane >> 4;
    const int dcp = lane & 15;
    const float* nw = p.in[14];
#pragma unroll 1
    for (int hl = 0; hl < 4; ++hl) { const int h = g * 4 + hl;
        const bf16* xth = XT + (size_t)(c * 8 + h) * 8192;
        const bf16* stf = STATE + ((size_t)c * 8 + h) * 8192; const bf16* stb = stf + (size_t)384 * 8 * 8192;
        __syncthreads();
#pragma unroll
        for (int k = 0; k < 2; ++k) { const int row = (wave * 2 + k) * 4 + dj; const int so = row * 128 + ((dcp ^ (row & 15)) * 8);
            __builtin_amdgcn_global_load_lds((const unsigned*)(xth + so), (PG8_LAS unsigned*)(tl + (wave * 2 + k) * 1024), 16, 0, 0);
            __builtin_amdgcn_global_load_lds((const unsigned*)(stf + so), (PG8_LAS unsigned*)(tl + 16384 + (wave * 2 + k) * 1024), 16, 0, 0);
            __builtin_amdgcn_global_load_lds((const unsigned*)(stb + so), (PG8_LAS unsigned*)(tl + 32768 + (wave * 2 + k) * 1024), 16, 0, 0); }
        asm volatile("s_waitcnt vmcnt(0)" ::: "memory");
        __syncthreads();
        const float af_l = acsf[hl * 128 + lrow], rb_l = rcsb[hl * 128 + lrow];
        f32x4 Y[4];
        {
            f32x4 Yf[4], Yb[4];
#pragma unroll
            for (int pt = 0; pt < 4; ++pt) { Yf[pt] = (f32x4){0.f, 0.f, 0.f, 0.f}; Yb[pt] = Yf[pt]; }
#pragma unroll
            for (int ks = 0; ks < 4; ++ks) {
#pragma unroll
                for (int pt = 0; pt < 4; ++pt) {
                    const int lo = (pt * 16 + fr) * 256 + (((ks * 4 + quad) ^ fr) * 16);
                    Yf[pt] = mfma16(cf[ks], *(const PG8_LAS bf16x8*)(tl + 16384 + lo), Yf[pt]);
                    Yb[pt] = mfma16(cf[ks], *(const PG8_LAS bf16x8*)(tl + 32768 + lo), Yb[pt]);
                }
            }
            const f32x4 ea = *(const f32x4*)(acsf + hl * 128 + l4), eb = *(const f32x4*)(rcsb + hl * 128 + l4);
            f32x4 xa, xb;
#pragma unroll
            for (int e = 0; e < 4; ++e) { xa[e] = __expf(ea[e]); xb[e] = __expf(eb[e]); }
#pragma unroll
            for (int pt = 0; pt < 4; ++pt) Y[pt] = xa * Yf[pt] + xb * Yb[pt];
        }
#pragma unroll
        for (int sp = 0; sp < 4; ++sp) { const int s0 = sp * 32 + quad * 8;
            float mv[8];
#pragma unroll
            for (int t = 0; t < 2; ++t) {
                const f32x4 afs = *(const f32x4*)(acsf + hl * 128 + s0 + 4 * t), rbs = *(const f32x4*)(rcsb + hl * 128 + s0 + 4 * t);
                const f32x4 dfs = *(const f32x4*)(dtf + hl * 128 + s0 + 4 * t), dbs = *(const f32x4*)(dtb + hl * 128 + s0 + 4 * t);
#pragma unroll
                for (int e = 0; e < 4; ++e) { const int s = s0 + 4 * t + e;
                    const float ef = __expf(fminf(af_l - afs[e], 0.f)) * dfs[e], eb2 = __expf(fminf(rb_l - rbs[e], 0.f)) * dbs[e];
                    const float vf = (s <= lrow) ? ef : 0.f;
                    const float vb = (s >= lrow) ? eb2 : 0.f;
                    mv[4 * t + e] = cb[sp][t][e] * (vf + vb); }
            }
            bf16x8 mf = pack8(mv); mfma_operand_pad(mf);
#pragma unroll
            for (int pt = 0; pt < 4; ++pt) Y[pt] = mfma16(mf, *(const PG8_LAS bf16x8*)(tl + (pt * 16 + fr) * 256 + (((sp * 4 + quad) ^ fr) * 16)), Y[pt]);
        }
        const float Dk = p.in[13][h];
#pragma unroll
        for (int pt = 0; pt < 4; ++pt) { const int pc = pt * 16 + fr;
            const u32x2 xw = *(const u32x2*)(xth + (size_t)pc * 128 + l4);
            const float xv[4] = {bf2f(xw.x & 0xffffu), bf2f(xw.x >> 16), bf2f(xw.y & 0xffffu), bf2f(xw.y >> 16)};
            const float wn = nw[h * 64 + pc];
#pragma unroll
            for (int e = 0; e < 4; ++e) { const size_t off = (size_t)(t0 + l4 + e) * 1024 + 512 + h * 64 + pc;
                const float zv = bf2f(VZ[off]);
                const float y = Y[pt][e] + Dk * xv[e];
                const float gg = y * silu(zv); ssq[e] += gg * gg;
                gsm[(quad * 4 + e) * 256 + hl * 64 + pc] = f2bf(gg * wn); }
        }
    }
#pragma unroll
    for (int e = 0; e < 4; ++e) { float ss = ssq[e];
        ss += __shfl_xor(ss, 1); ss += __shfl_xor(ss, 2); ss += __shfl_xor(ss, 4); ss += __shfl_xor(ss, 8);
        if (fr == 0) rsm[quad * 4 + e] = rsqrtf(ss * (1.f / 256.f) + EPS); }
    LDS_WAIT();
    { const int r = lane >> 2; const float rs = rsm[r];
        bf16* mp = MIX + (size_t)(t0 + 16 * wave + r) * 1024 + 512 + g * 256 + (lane & 3) * 64;
        const unsigned short* gp = gsm + r * 256 + (lane & 3) * 64;
#pragma unroll
        for (int it = 0; it < 8; ++it) { const u32x4 w = *(const u32x4*)(gp + it * 8);
            u32x4 o; o.x = pk2(bf2f(w.x & 0xffffu) * rs, bf2f(w.x >> 16) * rs); o.y = pk2(bf2f(w.y & 0xffffu) * rs, bf2f(w.y >> 16) * rs);
            o.z = pk2(bf2f(w.z & 0xffffu) * rs, bf2f(w.z >> 16) * rs); o.w = pk2(bf2f(w.w & 0xffffu) * rs, bf2f(w.w >> 16) * rs);
            *(u32x4*)(mp + it * 8) = o; }
    }
    __syncthreads();
}
using pg8::Unit;
struct EpiProj {
    static constexpr bool PERM = true, AFTER_DRAIN = false;
    bf16* O;
    __device__ __forceinline__ void operator()(const f32x4 (&acc)[2][2][4][2], const Unit& u, int wr, int wc, int fr, int fq) const {
        const int row0 = u.pm * 256 + wr * 64 + fr; const int colt = u.pn * 256; const int piece = colt >> 10;
        bf16* base = O + (size_t)piece * ((size_t)M * 1024) + (colt & 1023) + wc * 32 + 8 * fq;
#pragma unroll
        for (int ai = 0; ai < 2; ++ai)
#pragma unroll
            for (int m = 0; m < 4; ++m) { bf16* rowp = base + (size_t)(row0 + ai * 128 + m * 16) * 1024;
#pragma unroll
                for (int bj = 0; bj < 2; ++bj) { const f32x4 v0 = acc[ai][bj][m][0], v1 = acc[ai][bj][m][1];
                    u32x4 w; w.x = pk2(v0[0], v0[1]); w.y = pk2(v0[2], v0[3]); w.z = pk2(v1[0], v1[1]); w.w = pk2(v1[2], v1[3]);
                    *(u32x4*)(rowp + bj * 128) = w; } }
    }
};
struct EpiOut {
    static constexpr bool PERM = true, AFTER_DRAIN = false;
    const float* xp; const float* xs; float* out; bf16* xb; float* rowss;
    __device__ __forceinline__ void operator()(const f32x4 (&acc)[2][2][4][2], const Unit& u, int wr, int wc, int fr, int fq) const {
        const int row0 = u.pm * 256 + wr * 64 + fr; const int col0 = u.pn * 256 + wc * 32 + 8 * fq;
#pragma unroll
        for (int ai = 0; ai < 2; ++ai)
#pragma unroll
            for (int m = 0; m < 4; ++m) { const int row = row0 + ai * 128 + m * 16;
                const float* xr = (row < MP ? xp + (size_t)row * 1024 : xs + (size_t)(row - MP) * 1024) + col0;
                float ss = 0.f;
#pragma unroll
                for (int bj = 0; bj < 2; ++bj) {
                    const f32x4 v0 = acc[ai][bj][m][0] + *(const f32x4*)(xr + bj * 128), v1 = acc[ai][bj][m][1] + *(const f32x4*)(xr + bj * 128 + 4);
                    u32x4 w; w.x = pk2(v0[0], v0[1]); w.y = pk2(v0[2], v0[3]); w.z = pk2(v1[0], v1[1]); w.w = pk2(v1[2], v1[3]);
                    *(u32x4*)(xb + (size_t)row * 1024 + col0 + bj * 128) = w;
                    ss += (v0[0] * v0[0] + v0[1] * v0[1]) + (v0[2] * v0[2] + v0[3] * v0[3]) + (v1[0] * v1[0] + v1[1] * v1[1]) + (v1[2] * v1[2] + v1[3] * v1[3]); }
                ss += __shfl_xor(ss, 16); ss += __shfl_xor(ss, 32);
                if (fq == 0) rowss[((size_t)u.pn * M + row) * 4 + wc] = ss; }
    }
};
struct EpiGU {
    static constexpr bool PERM = true, AFTER_DRAIN = false;
    bf16* hid; const float* rowss;
    __device__ __forceinline__ void operator()(const f32x4 (&acc)[2][2][4][2], const Unit& u, int wr, int wc, int fr, int fq) const {
        const int row0 = u.pm * 256 + wr * 64 + fr; const int col0 = u.pn * 128 + wc * 32 + 8 * fq;
#pragma unroll
        for (int ai = 0; ai < 2; ++ai)
#pragma unroll
            for (int m = 0; m < 4; ++m) { const int row = row0 + ai * 128 + m * 16;
                const f32x4* pp = (const f32x4*)(rowss + (size_t)row * 4); const f32x4 q0 = pp[0], q1 = pp[M], q2 = pp[2 * M], q3 = pp[3 * M];
                const float rsum = ((q0[0] + q0[1]) + (q0[2] + q0[3])) + ((q1[0] + q1[1]) + (q1[2] + q1[3])) + ((q2[0] + q2[1]) + (q2[2] + q2[3])) + ((q3[0] + q3[1]) + (q3[2] + q3[3]));
                const float rstd = rsqrtf(rsum * (1.f / 1024.f) + EPS);
                float hv[8];
#pragma unroll
                for (int n = 0; n < 2; ++n)
#pragma unroll
                    for (int e = 0; e < 4; ++e) { const float gt = acc[ai][0][m][n][e] * rstd, up = acc[ai][1][m][n][e] * rstd; hv[4 * n + e] = silu(gt) * up; }
                *(bf16x8*)(hid + (size_t)row * 2816 + col0) = pack8(hv); }
    }
};
struct EpiDown {
    static constexpr bool PERM = true, AFTER_DRAIN = false;
    float* out; const bf16* xb;
    __device__ __forceinline__ void operator()(const f32x4 (&acc)[2][2][4][2], const Unit& u, int wr, int wc, int fr, int fq) const {
        const int row0 = u.pm * 256 + wr * 64 + fr; const int col0 = u.pn * 256 + wc * 32 + 8 * fq;
#pragma unroll
        for (int ai = 0; ai < 2; ++ai)
#pragma unroll
            for (int m = 0; m < 4; ++m) { const size_t off = (size_t)(row0 + ai * 128 + m * 16) * 1024 + col0;
#pragma unroll
                for (int bj = 0; bj < 2; ++bj) { const u32x4 w = *(const u32x4*)(xb + off + bj * 128);
                    f32x4 a0, a1; a0[0] = bf2f(w.x & 0xffffu); a0[1] = bf2f(w.x >> 16); a0[2] = bf2f(w.y & 0xffffu); a0[3] = bf2f(w.y >> 16);
                    a1[0] = bf2f(w.z & 0xffffu); a1[1] = bf2f(w.z >> 16); a1[2] = bf2f(w.w & 0xffffu); a1[3] = bf2f(w.w >> 16);
                    *(f32x4*)(out + off + bj * 128) = a0 + acc[ai][bj][m][0]; *(f32x4*)(out + off + bj * 128 + 4) = a1 + acc[ai][bj][m][1]; } }
    }
};

#define LAS __attribute__((address_space(3)))
#define XB_TMO      128
#define XB_XCNT(j)  (256  + 64 * (j))
#define XB_XSUB(j)  (1280 + 64 * (j))
#define XB_XGEN(j)  (2304 + 64 * (j))
#define XB_TOP      3328
#define XB_TOPGEN   3392
#define XCD_BAR_WORDS 3456
#define XB_SPIN_CAP (1u << 18)

__device__ __forceinline__ unsigned xb_ld(unsigned* p)              { return __hip_atomic_load(p, __ATOMIC_RELAXED, __HIP_MEMORY_SCOPE_AGENT); }
__device__ __forceinline__ unsigned xb_add(unsigned* p, unsigned v) { return __hip_atomic_fetch_add(p, v, __ATOMIC_RELAXED, __HIP_MEMORY_SCOPE_AGENT); }
__device__ __forceinline__ unsigned xb_xcc_id() { return (unsigned)__builtin_amdgcn_s_getreg((3 << 11) | 20) & 0xFu; }
#define XB_SPIN(cond, bar) do { unsigned _sp = 0; while (cond) { __builtin_amdgcn_s_sleep(1); \
    if ((++_sp & 255u) == 0u) { if (xb_ld(&(bar)[XB_TMO])) break; if (_sp > XB_SPIN_CAP) { atomicAdd(&(bar)[XB_TMO], 1u); break; } } } } while (0)

struct XcdBarrier {
    unsigned* bar; unsigned x;
    volatile LAS unsigned* st;
};

__device__ __forceinline__ XcdBarrier xcd_barrier_post(unsigned* bar, volatile LAS unsigned* st) {
    XcdBarrier b; b.bar = bar; b.x = xb_xcc_id(); b.st = st;
    if (threadIdx.x == 0) (void)xb_add(&bar[XB_XCNT(b.x)], 1u);
    return b;
}
__device__ __forceinline__ void xcd_barrier_complete(unsigned* bar, unsigned x, unsigned& nloc, unsigned& nx) {
    const unsigned G = gridDim.x * gridDim.y * gridDim.z;
    unsigned sum, cnt, mine, sp = 0u;
    for (;;) {
        sum = 0u; cnt = 0u; mine = 0u;
#pragma unroll
        for (unsigned j = 0; j < 16; ++j) { const unsigned c = xb_ld(&bar[XB_XCNT(j)]); sum += c; cnt += (c > 0u) ? 1u : 0u; mine = (j == x) ? c : mine; }
        if (sum == G) break;
        __builtin_amdgcn_s_sleep(1);
        if ((++sp & 255u) == 0u) { if (xb_ld(&bar[XB_TMO])) break; if (sp > XB_SPIN_CAP) { atomicAdd(&bar[XB_TMO], 1u); break; } }
    }
    nloc = mine > 0u ? mine : 1u; nx = cnt > 0u ? cnt : 1u;
}

__device__ __forceinline__ void xcd_barrier(const XcdBarrier& b) {
    asm volatile("s_waitcnt vmcnt(0)" ::: "memory");
    __syncthreads();
    if (threadIdx.x == 0) {
        unsigned* bar = b.bar;
        __builtin_amdgcn_s_waitcnt(0);
        unsigned nloc = b.st[0], nx = b.st[1];
        if (nloc == 0u) { xcd_barrier_complete(bar, b.x, nloc, nx); b.st[0] = nloc; b.st[1] = nx; }
        const unsigned old = xb_add(&bar[XB_XSUB(b.x)], 1u);
        const unsigned gen = old / nloc;
        if (old + 1u == (gen + 1u) * nloc) {
            __builtin_amdgcn_fence(__ATOMIC_RELEASE, "agent");
            asm volatile("s_waitcnt vmcnt(0)" ::: "memory");
            const unsigned og = xb_add(&bar[XB_TOP], 1u);
            const unsigned tg = og / nx;
            if (og + 1u == (tg + 1u) * nx) xb_add(&bar[XB_TOPGEN], 1u);
            else XB_SPIN(xb_ld(&bar[XB_TOPGEN]) == tg, bar);
            __builtin_amdgcn_fence(__ATOMIC_ACQUIRE, "agent");
            xb_add(&bar[XB_XGEN(b.x)], 1u);
            asm volatile("s_waitcnt vmcnt(0)" ::: "memory");
        } else {
            XB_SPIN(xb_ld(&bar[XB_XGEN(b.x)]) == gen, bar);
            __builtin_amdgcn_fence(__ATOMIC_ACQUIRE, "agent");
            asm volatile("s_waitcnt vmcnt(0)" ::: "memory");
        }
    }
    __syncthreads();
}


__device__ __forceinline__ void gsync(cg::grid_group& grid) {
    asm volatile("s_waitcnt vmcnt(0) lgkmcnt(0)" ::: "memory");
    __syncthreads();
    grid.sync();
    __builtin_amdgcn_fence(__ATOMIC_ACQUIRE, "agent");
    asm volatile("s_waitcnt vmcnt(0)" ::: "memory");
    __syncthreads();
}
constexpr int LDS_BYTES = 147456;
__global__ void __launch_bounds__(512, 2) hymba_fwd(Params p) {
    extern __shared__ __attribute__((aligned(16))) unsigned char lds[];
    cg::grid_group grid = cg::this_grid();
    const int tid = threadIdx.x, lane = tid & 63, wave = __builtin_amdgcn_readfirstlane(tid >> 6), G = gridDim.x;
    PG8_LAS unsigned char* glds = (PG8_LAS unsigned char*)lds;
    volatile LAS unsigned* MISC = (volatile LAS unsigned*)((LAS unsigned char*)lds + (LDS_BYTES - 64));
    if (tid < 16) MISC[tid] = 0u;
    unsigned* barw = (unsigned*)(p.ws + WS_BAR);
    if (blockIdx.x == 0) for (int i = tid; i < XCD_BAR_WORDS; i += 512) __hip_atomic_store(barw + i, 0u, __ATOMIC_RELAXED, __HIP_MEMORY_SCOPE_AGENT);
    __syncthreads();

#ifndef SKIP_P0
    phase0(p, lds, tid, lane, wave, G);
#endif
    gsync(grid);
    const XcdBarrier xbar = xcd_barrier_post(barw, MISC + 8);
#ifndef SKIP_P1
    { pg8::Gemm g{(const bf16*)(p.ws + WS_XN), (const bf16*)(p.ws + WS_WIN), M, 3072, 1024}; pg8::StaticOrder S; S.init(M, 3072, G, (int)blockIdx.x);
      EpiProj E{(bf16*)(p.ws + WS_QK)};
      pg8::gemm_phase<EpiProj, pg8::StaticOrder, true, true>(glds, g, S, E); }
#endif
    xcd_barrier(xbar);
#ifndef SKIP_P2
    phase2(p, lds, tid, lane, wave, G);
#endif
    xcd_barrier(xbar);
    { float* rpbs = (float*)lds; float* wts = (float*)(lds + 16384);
      for (int i = tid; i < 8 * 15 * 31; i += 512) rpbs[i] = p.in[6][i];
      __syncthreads();
#ifndef SKIP_P3A
      const int vcu = (G % 8 == 0) ? (int)(blockIdx.x % 8) * (G / 8) + (int)(blockIdx.x / 8) : (int)blockIdx.x;
      for (int U = vcu; U < 1536; U += G) attn_unit(p, rpbs, (unsigned short*)(lds + 86016 + wave * 2304), U >> 1, (U & 1) * 4 + (wave & 3), (wave >> 2) * 2, lane);
#endif
#ifndef SKIP_P3B
      for (int u = vcu; u < 384 * 8; u += G) s1_unit(p, wts, u, lane, wave);
#endif
    }
    xcd_barrier(xbar);
#ifndef SKIP_P4
    phase_scan(p, tid, G);
#endif
    xcd_barrier(xbar);
#ifndef SKIP_P5
    for (int u = blockIdx.x; u < 768; u += G) s3_unit(p, lds, u, lane, wave);
#endif
    xcd_barrier(xbar);
#ifndef SKIP_P6
    { pg8::Gemm g{(const bf16*)(p.ws + WS_MIX), (const bf16*)(p.ws + WS_WOUT), M, 1024, 1024}; pg8::StaticOrder S; S.init(M, 1024, G, (int)blockIdx.x);
      EpiOut E{p.in[0], p.in[1], p.out, (bf16*)(p.ws + WS_XN), (float*)(p.ws + WS_PART)};
      pg8::gemm_phase<EpiOut, pg8::StaticOrder, true, true>(glds, g, S, E); }
#endif
    xcd_barrier(xbar);
#ifndef SKIP_P7
    { pg8::Gemm g{(const bf16*)(p.ws + WS_XN), (const bf16*)(p.ws + WS_WGU), M, 5632, 1024}; pg8::StaticOrder S; S.init(M, 5632, G, (int)blockIdx.x);
      EpiGU E{(bf16*)(p.ws + WS_HID), (const float*)(p.ws + WS_PART)};
      pg8::gemm_phase<EpiGU, pg8::StaticOrder, true, true>(glds, g, S, E); }
#endif
    xcd_barrier(xbar);
#ifndef SKIP_P8
    { pg8::Gemm g{(const bf16*)(p.ws + WS_HID), (const bf16*)(p.ws + WS_WDN), M, 1024, 2816}; pg8::StaticOrder S; S.init(M, 1024, G, (int)blockIdx.x);
      EpiDown E{p.out, (const bf16*)(p.ws + WS_XN)};
      pg8::gemm_phase<EpiDown, pg8::StaticOrder, true, true>(glds, g, S, E); }
#endif
}
}

extern "C" void kernel_launch(void* const* d_in, const int* in_sizes, int n_in, void* d_out, int out_size, void* d_ws, size_t ws_size, hipStream_t stream) {
    static int grid = 0;
    if (grid == 0) {
        if (n_in != 20 || out_size != hk::M * 1024 || ws_size < hk::WS_END) { fprintf(stderr, "kernel_launch: unexpected shapes (n_in %d out %d ws %zu)\n", n_in, out_size, ws_size); grid = -1; return; }
        int dev = 0, cus = 0, per_cu = 0;
        if (hipGetDevice(&dev) != hipSuccess || hipDeviceGetAttribute(&cus, hipDeviceAttributeMultiprocessorCount, dev) != hipSuccess) { grid = -1; return; }
        if (hipFuncSetAttribute((const void*)hk::hymba_fwd, hipFuncAttributeMaxDynamicSharedMemorySize, hk::LDS_BYTES) != hipSuccess) { fprintf(stderr, "kernel_launch: hipFuncSetAttribute failed\n"); grid = -1; return; }
        if (hipOccupancyMaxActiveBlocksPerMultiprocessor(&per_cu, (const void*)hk::hymba_fwd, 512, hk::LDS_BYTES) != hipSuccess || per_cu < 1) { fprintf(stderr, "kernel_launch: occupancy query says %d\n", per_cu); (void)hipGetLastError(); grid = -1; return; }
        grid = cus * 1;
    }
    if (grid < 0) return;
    hk::Params prm{};
    for (int i = 0; i < 20; ++i) prm.in[i] = (const float*)d_in[i];
    prm.out = (float*)d_out; prm.ws = (unsigned char*)d_ws;
    void* args[] = {&prm};
    hipError_t e = hipLaunchCooperativeKernel((const void*)hk::hymba_fwd, dim3(grid), dim3(512), args, hk::LDS_BYTES, stream);
    if (e != hipSuccess) fprintf(stderr, "cooperative launch failed: %s (grid %d)\n", hipGetErrorString(e), grid);
}
```

```cpp
#include <hip/hip_runtime.h>
#include <hip/hip_cooperative_groups.h>
#include <cstdio>
#include <cstdint>
namespace cg = cooperative_groups;
namespace pg8 {
#define PG8_LAS __attribute__((address_space(3)))
typedef unsigned short bf16_t;
typedef short bf16x8 __attribute__((ext_vector_type(8)));
typedef float f32x4 __attribute__((ext_vector_type(4)));
typedef unsigned u32x4 __attribute__((ext_vector_type(4)));
constexpr int BM = 256, BK = 64, HALF = 128, HTB = HALF * BK * 2  , STAGE_BYTES = 8 * HTB, NXCD = 8, WGM = 4;

__host__ __device__ __forceinline__ int lds_byte(int r, int c) { const int st = (r >> 4) * 2 + (c >> 5), rr = r & 15, cc = c & 31, ob = rr * 64 + cc * 2; return st * 1024 + (ob ^ (((ob >> 9) & 1) << 5)); }
__host__ __device__ __forceinline__ void stage_rc(int b, int& R, int& C) { const int st = b / 1024, sb = b % 1024, swz = sb ^ (((sb >> 9) & 1) << 5); R = (st >> 1) * 16 + swz / 64; C = (st & 1) * 32 + (swz % 64) / 2; }
__host__ __device__ __forceinline__ int perm32(int rho) { const int n = rho >> 4, i = rho & 15; return 8 * (i >> 2) + 4 * n + (i & 3); }

struct Unit { int pm, pn; };
struct Gemm { const bf16_t* A; const bf16_t* Bt; int M, N, K; };

struct StaticOrder {
    int nM, nN, nwg, G, c;
    __host__ __device__ void init(int M, int N, int G_, int c_) { nM = M / BM; nN = N / BM; nwg = nM * nN; G = G_; c = c_; }
    __host__ __device__ bool next(int i, Unit& u) const {
        const long L = (long)i * G + c; if (L >= nwg) return false;
        int wgid = (int)L; { const int q = nwg / NXCD, r = nwg % NXCD, xcd = wgid % NXCD, off = wgid / NXCD; wgid = (xcd < r ? xcd * (q + 1) : r * (q + 1) + (xcd - r) * q) + off; }
        const int nig = WGM * nN, gid = wgid / nig, fm = gid * WGM, gsz = (nM - fm) < WGM ? (nM - fm) : WGM;
        u.pm = fm + ((wgid % nig) % gsz); u.pn = (wgid % nig) / gsz; return true;
    }
    __device__ __forceinline__ void a_ready(const Unit&) const {}
    __device__ __forceinline__ void done(const Unit&) const {}
};

__device__ __forceinline__ unsigned cvt_pk_bf16(float lo, float hi) { unsigned r; asm volatile("v_cvt_pk_bf16_f32 %0, %1, %2" : "=v"(r) : "v"(lo), "v"(hi)); return r; }
template <class Epi, class Sched, bool ALIGN_EPI = false, bool SP2 = false>
__device__ __forceinline__ void gemm_phase(PG8_LAS unsigned char* lds, const Gemm g, const Sched& S, const Epi& E) {
    const int tid = threadIdx.x, wid = __builtin_amdgcn_readfirstlane(tid >> 6), lane = tid & 63, wr = wid >> 2, wc = wid & 3, fr = lane & 15, fq = lane >> 4;
    const int K = g.K, nt = K / BK;
    unsigned voffA[2], voffB[2];
#pragma unroll
    for (int i = 0; i < 2; ++i) { int R, C; stage_rc(tid * 16 + i * 8192, R, C); const int Rb = Epi::PERM ? ((R & ~31) + perm32(R & 31)) : R;
        voffA[i] = (unsigned)(R * K + C) * 2u; voffB[i] = (unsigned)(Rb * K + C) * 2u; }
    const size_t kstep = (size_t)(BK * 2);
    const size_t hstep = (size_t)HALF * K * 2;
    const size_t tstep = 2 * hstep;
    const unsigned ldsw = (unsigned)wid * 1024u;
    const int aoff = lds_byte(wr * 64 + fr, fq * 8), boff = lds_byte(wc * 32 + fr, fq * 8);
#define PG8_SA(b, h) (((b) * 2 + (h)) * HTB)
#define PG8_SB(b, h) ((4 + (b) * 2 + (h)) * HTB)
#define PG8_STAGE(bufoff, gbase, voff) do { _Pragma("unroll") for (int _i = 0; _i < 2; ++_i) \
        __builtin_amdgcn_global_load_lds((const unsigned*)((const char*)(gbase) + (voff)[_i]), (PG8_LAS unsigned*)(lds + (bufoff) + ldsw + _i * 8192), 16, 0, 0); } while (0)
#define PG8_LDA(dst, b, h) do { _Pragma("unroll") for (int m = 0; m < 4; ++m) _Pragma("unroll") for (int k = 0; k < 2; ++k) dst[m][k] = *(const PG8_LAS bf16x8*)(lds + PG8_SA(b, h) + aoff + m * 2048 + k * 1024); } while (0)
#define PG8_LDB(dst, b, h) do { _Pragma("unroll") for (int n = 0; n < 2; ++n) _Pragma("unroll") for (int k = 0; k < 2; ++k) dst[n][k] = *(const PG8_LAS bf16x8*)(lds + PG8_SB(b, h) + boff + n * 2048 + k * 1024); } while (0)
#define PG8_MMA(ai, bj, At, Bt) do { __builtin_amdgcn_s_setprio(1); _Pragma("unroll") for (int m = 0; m < 4; ++m) _Pragma("unroll") for (int n = 0; n < 2; ++n) _Pragma("unroll") for (int k = 0; k < 2; ++k) \
        acc[ai][bj][m][n] = __builtin_amdgcn_mfma_f32_16x16x32_bf16(Bt[n][k], At[m][k], acc[ai][bj][m][n], 0, 0, 0); __builtin_amdgcn_s_setprio(0); } while (0)
#define PG8_WAIT_V(n) asm volatile("s_waitcnt vmcnt(" #n ")" ::: "memory")
#define PG8_WAIT_L(n) asm volatile("s_waitcnt lgkmcnt(" #n ")" ::: "memory")
#define PG8_BAR __builtin_amdgcn_s_barrier()
#define PG8_SCHED __builtin_amdgcn_sched_barrier(0)
    Unit cur, nxt; int ui = 0;
    if (!S.next(0, cur)) return;
    f32x4 acc[2][2][4][2];
#pragma unroll
    for (int a = 0; a < 2; ++a)
#pragma unroll
        for (int b = 0; b < 2; ++b)
#pragma unroll
            for (int m = 0; m < 4; ++m)
#pragma unroll
                for (int n = 0; n < 2; ++n) acc[a][b][m][n] = (f32x4){0.f, 0.f, 0.f, 0.f};
    bf16x8 At[4][2], B0[2][2], B1[2][2];
    const char* cA = (const char*)g.A + (size_t)cur.pm * tstep; const char* cB = (const char*)g.Bt + (size_t)cur.pn * tstep;
    S.a_ready(cur);
    if constexpr (SP2) {
        PG8_STAGE(PG8_SB(0, 0), cB, voffB); PG8_STAGE(PG8_SB(0, 1), cB + hstep, voffB); PG8_STAGE(PG8_SA(0, 0), cA, voffA); PG8_STAGE(PG8_SA(0, 1), cA + hstep, voffA);
        if (wr == 1) PG8_BAR;
        PG8_WAIT_V(2); PG8_BAR;
        PG8_STAGE(PG8_SB(1, 0), cB + kstep, voffB); PG8_STAGE(PG8_SA(1, 0), cA + kstep, voffA); PG8_STAGE(PG8_SB(1, 1), cB + hstep + kstep, voffB);
        PG8_WAIT_V(6); PG8_BAR;
    } else {
        PG8_STAGE(PG8_SB(0, 0), cB, voffB); PG8_STAGE(PG8_SA(0, 0), cA, voffA); PG8_STAGE(PG8_SB(0, 1), cB + hstep, voffB); PG8_STAGE(PG8_SA(0, 1), cA + hstep, voffA);
        if (wr == 1) PG8_BAR;
        PG8_WAIT_V(4); PG8_BAR;
        PG8_STAGE(PG8_SB(1, 0), cB + kstep, voffB); PG8_STAGE(PG8_SA(1, 0), cA + kstep, voffA); PG8_STAGE(PG8_SB(1, 1), cB + hstep + kstep, voffB);
        PG8_WAIT_V(6); PG8_BAR;
    }
    for (;;) {
        const bool has_next = S.next(ui + 1, nxt);
        const char* nA = has_next ? (const char*)g.A + (size_t)nxt.pm * tstep : cA; const char* nB = has_next ? (const char*)g.Bt + (size_t)nxt.pn * tstep : cB;
        for (int t = 0; t < nt; t += 2) {
            const bool last = (t == nt - 2);
            const char* a1 = cA + (size_t)(t + 1) * kstep;
            const char* a2 = last ? nA : cA + (size_t)(t + 2) * kstep; const char* b2 = last ? nB : cB + (size_t)(t + 2) * kstep;
            const char* a3 = a2 + kstep; const char* b3 = b2 + kstep;
            if (last && has_next) S.a_ready(nxt);
            if constexpr (SP2) {
            PG8_LDB(B0, 0, 0); PG8_LDB(B1, 0, 1); PG8_SCHED; PG8_LDA(At, 0, 0); PG8_STAGE(PG8_SA(1, 1), a1 + hstep, voffA);
            PG8_WAIT_V(8); PG8_WAIT_L(0); PG8_BAR; PG8_MMA(0, 0, At, B0); PG8_MMA(0, 1, At, B1); PG8_BAR; PG8_SCHED;
            PG8_LDA(At, 0, 1); PG8_STAGE(PG8_SB(0, 0), b2, voffB); PG8_STAGE(PG8_SB(0, 1), b2 + hstep, voffB); PG8_STAGE(PG8_SA(0, 0), a2, voffA);
            PG8_WAIT_V(8); PG8_WAIT_L(0); PG8_BAR; PG8_MMA(1, 0, At, B0); PG8_MMA(1, 1, At, B1); PG8_BAR; PG8_SCHED;
            PG8_LDB(B0, 1, 0); PG8_LDB(B1, 1, 1); PG8_SCHED; PG8_LDA(At, 1, 0); PG8_STAGE(PG8_SA(0, 1), a2 + hstep, voffA);
            PG8_WAIT_V(8); PG8_WAIT_L(0); PG8_BAR; PG8_MMA(0, 0, At, B0); PG8_MMA(0, 1, At, B1); PG8_BAR; PG8_SCHED;
            PG8_LDA(At, 1, 1); PG8_STAGE(PG8_SB(1, 0), b3, voffB); PG8_STAGE(PG8_SB(1, 1), b3 + hstep, voffB); PG8_STAGE(PG8_SA(1, 0), a3, voffA);
            PG8_WAIT_V(8); PG8_WAIT_L(0); PG8_BAR; PG8_MMA(1, 0, At, B0); PG8_MMA(1, 1, At, B1); PG8_BAR; PG8_SCHED;
            } else {
            PG8_LDB(B0, 0, 0); PG8_SCHED; PG8_LDA(At, 0, 0); PG8_STAGE(PG8_SA(1, 1), a1 + hstep, voffA);
            PG8_WAIT_L(8); PG8_BAR; PG8_WAIT_L(0); PG8_MMA(0, 0, At, B0); PG8_BAR; PG8_SCHED;
            PG8_LDB(B1, 0, 1); PG8_STAGE(PG8_SB(0, 0), b2, voffB);
            PG8_BAR; PG8_WAIT_L(0); PG8_MMA(0, 1, At, B1); PG8_BAR;
            PG8_LDA(At, 0, 1); PG8_STAGE(PG8_SA(0, 0), a2, voffA);
            PG8_BAR; PG8_WAIT_L(0); PG8_MMA(1, 0, At, B0); PG8_BAR; PG8_SCHED;
            PG8_STAGE(PG8_SB(0, 1), b2 + hstep, voffB);
            PG8_WAIT_V(6); PG8_BAR; PG8_MMA(1, 1, At, B1); PG8_BAR;
            PG8_LDB(B0, 1, 0); PG8_SCHED; PG8_LDA(At, 1, 0); PG8_STAGE(PG8_SA(0, 1), a2 + hstep, voffA);
            PG8_WAIT_L(8); PG8_BAR; PG8_WAIT_L(0); PG8_MMA(0, 0, At, B0); PG8_BAR; PG8_SCHED;
            PG8_LDB(B1, 1, 1); PG8_STAGE(PG8_SB(1, 0), b3, voffB);
            PG8_BAR; PG8_WAIT_L(0); PG8_MMA(0, 1, At, B1); PG8_BAR;
            PG8_LDA(At, 1, 1); PG8_STAGE(PG8_SA(1, 0), a3, voffA);
            PG8_BAR; PG8_WAIT_L(0); PG8_MMA(1, 0, At, B0); PG8_BAR; PG8_SCHED;
            PG8_STAGE(PG8_SB(1, 1), b3 + hstep, voffB);
            PG8_WAIT_V(6); PG8_BAR; PG8_MMA(1, 1, At, B1); PG8_BAR;
            }
        }
        if constexpr (ALIGN_EPI) { if (wr == 0) PG8_BAR; }
        if constexpr (!Epi::AFTER_DRAIN) { E(acc, cur, wr, wc, fr, fq); S.done(cur); }
        if (!has_next) break;
#pragma unroll
        for (int a = 0; a < 2; ++a)
#pragma unroll
            for (int b = 0; b < 2; ++b)
#pragma unroll
                for (int m = 0; m < 4; ++m)
#pragma unroll
                    for (int n = 0; n < 2; ++n) acc[a][b][m][n] = (f32x4){0.f, 0.f, 0.f, 0.f};
        cur = nxt; cA = nA; cB = nB; ++ui;
        if constexpr (ALIGN_EPI) { if (wr == 1) PG8_BAR; }
    }
    PG8_WAIT_V(0);
    if constexpr (!ALIGN_EPI) { if (wr == 0) PG8_BAR; }
    PG8_BAR;
    if constexpr (Epi::AFTER_DRAIN) { E.fused(acc, cur, wr, wc, fr, fq, lds, wid, lane); S.done(cur); }
#undef PG8_SA
#undef PG8_SB
#undef PG8_STAGE
#undef PG8_LDA
#undef PG8_LDB
#undef PG8_MMA
#undef PG8_WAIT_V
#undef PG8_WAIT_L
#undef PG8_BAR
#undef PG8_SCHED
}
}
namespace hk {
typedef unsigned short bf16;
typedef short bf16x8 __attribute__((ext_vector_type(8)));
typedef float f32x4 __attribute__((ext_vector_type(4)));
typedef unsigned u32x4 __attribute__((ext_vector_type(4)));
typedef unsigned u32x2 __attribute__((ext_vector_type(2)));

constexpr int M = 49152, MP = 16384;
constexpr float EPS = 1e-6f;
constexpr size_t MiB = 1u << 20;
constexpr size_t WS_PART = 29 * MiB;
constexpr size_t WS_CDEC = 0;
constexpr size_t WS_BAR = 800 * 1024;
constexpr size_t WS_DT = 1 * MiB;
constexpr size_t WS_WIN = 4 * MiB, WS_WOUT = 10 * MiB, WS_WGU = 12 * MiB, WS_WDN = 23 * MiB;
constexpr size_t WS_XN = 32 * MiB;
constexpr size_t WS_QK = 128 * MiB, WS_VZ = 224 * MiB, WS_XBC = 320 * MiB;
constexpr size_t WS_HID = 128 * MiB;
constexpr size_t WS_MIX = 416 * MiB;
constexpr size_t WS_END = 512 * MiB;
constexpr size_t DO_XT = 0, DO_BROW = 48 * MiB, DO_BT = 72 * MiB, DO_CROW = 96 * MiB, DO_VT = 120 * MiB;

struct Params { const float* in[20]; float* out; unsigned char* ws; };

__device__ __forceinline__ float bf2f(unsigned v) { return __uint_as_float(v << 16); }
typedef float f32x2_t __attribute__((ext_vector_type(2))); typedef __bf16 bf16x2_t __attribute__((ext_vector_type(2)));
__device__ __forceinline__ unsigned pk2c(float lo, float hi) { f32x2_t v = {lo, hi}; bf16x2_t b = __builtin_convertvector(v, bf16x2_t); return __builtin_bit_cast(unsigned, b); }
__device__ __forceinline__ unsigned pk2(float lo, float hi) { return pg8::cvt_pk_bf16(lo, hi); }
__device__ __forceinline__ unsigned short f2bf(float f) { return (unsigned short)(pk2(f, 0.f) & 0xffffu); }
__device__ __forceinline__ f32x4 mfma16(bf16x8 a, bf16x8 b, f32x4 c) { return __builtin_amdgcn_mfma_f32_16x16x32_bf16(a, b, c, 0, 0, 0); }
__device__ __forceinline__ float wave_sum(float v) {
#pragma unroll
    for (int o = 1; o < 64; o <<= 1) v += __shfl_xor(v, o);
    return v;
}
__device__ __forceinline__ float silu(float x) { return x * __builtin_amdgcn_rcpf(1.f + __expf(-x)); }
__device__ __forceinline__ bf16x8 pack8(const float (&f)[8]) {
    u32x4 w; w.x = pk2(f[0], f[1]); w.y = pk2(f[2], f[3]); w.z = pk2(f[4], f[5]); w.w = pk2(f[6], f[7]);
    return __builtin_bit_cast(bf16x8, w);
}
__device__ __forceinline__ bf16x8 pack8m(const float (&f)[8]) {
    u32x4 w; w.x = pk2c(f[0], f[1]); w.y = pk2c(f[2], f[3]); w.z = pk2c(f[4], f[5]); w.w = pk2c(f[6], f[7]);
    return __builtin_bit_cast(bf16x8, w);
}
#define LDS_WAIT() asm volatile("s_waitcnt lgkmcnt(0)" ::: "memory")
__device__ __forceinline__ void mfma_operand_pad(bf16x8& f) { asm volatile("s_nop 7" : "+v"(f)); }

__device__ __forceinline__ void wave_scan2(float a0, float a1, int lane, float& p0, float& p1, float& tot) {
    const float s = a0 + a1; float inc = s;
#pragma unroll
    for (int o = 1; o < 64; o <<= 1) { const float t = __shfl_up(inc, o); if (lane >= o) inc += t; }
    const float excl = inc - s;
    p0 = excl + a0; p1 = p0 + a1; tot = __shfl(inc, 63);
}

__device__ __forceinline__ void tr_item(const float* __restrict__ W, int ldw, int K, int col0, bf16* WT, int dstrow0, const float* __restrict__ kscale, float* scr, int k0, int lane) {
#pragma unroll 8
    for (int i = 0; i < 32; ++i) { const int kk = 2 * i + (lane >> 5); scr[kk * 33 + (lane & 31)] = W[(size_t)(k0 + kk) * ldw + col0 + (lane & 31)]; }
    LDS_WAIT();
    const int c = lane & 7;
    float ks[8];
#pragma unroll
    for (int i = 0; i < 8; ++i) ks[i] = kscale ? kscale[k0 + 8 * c + i] : 1.f;
#pragma unroll
    for (int j = 0; j < 4; ++j) { const int n = (lane >> 3) + 8 * j; const float* s = scr + (8 * c) * 33 + n;
        u32x4 o; o.x = pk2(s[0 * 33] * ks[0], s[1 * 33] * ks[1]); o.y = pk2(s[2 * 33] * ks[2], s[3 * 33] * ks[3]);
        o.z = pk2(s[4 * 33] * ks[4], s[5 * 33] * ks[5]); o.w = pk2(s[6 * 33] * ks[6], s[7 * 33] * ks[7]);
        *(u32x4*)(WT + (size_t)(dstrow0 + n) * K + k0 + 8 * c) = o; }
    LDS_WAIT();
}

__device__ __forceinline__ void phase0(const Params& p, unsigned char* lds, int tid, int lane, int wave, int G) {
    const int gw = blockIdx.x * 8 + wave, NGW = G * 8;
    float* scr = (float*)(lds + 65536 + wave * 8448);
    const float* norm1_w = p.in[2]; const float* w_in = p.in[3]; const float* w_out = p.in[15]; const float* norm2_w = p.in[16];
    const float* w_gate = p.in[17]; const float* w_up = p.in[18]; const float* w_down = p.in[19];
    bf16* Win_t = (bf16*)(p.ws + WS_WIN); bf16* Wout_t = (bf16*)(p.ws + WS_WOUT); bf16* Wgu_t = (bf16*)(p.ws + WS_WGU); bf16* Wdn_t = (bf16*)(p.ws + WS_WDN);
    constexpr int I_IN = 16 * 96, I_OUT = 16 * 32, I_G = 16 * 88, I_DN = 44 * 32, NIT = I_IN + I_OUT + 2 * I_G + I_DN;
    for (int it = gw; it < NIT; it += NGW) {
        int r = it;
        if (r < I_IN) { const int kb = r / 96, nb = r % 96; tr_item(w_in, 3088, 1024, nb * 32, Win_t, nb * 32, norm1_w, scr, kb * 64, lane); continue; } r -= I_IN;
        if (r < I_OUT) { const int kb = r / 32, nb = r % 32; tr_item(w_out, 1024, 1024, nb * 32, Wout_t, nb * 32, nullptr, scr, kb * 64, lane); continue; } r -= I_OUT;
        if (r < I_G) { const int kb = r / 88, nb = r % 88, c0 = nb * 32; tr_item(w_gate, 2816, 1024, c0, Wgu_t, (c0 >> 7) * 256 + (c0 & 127), norm2_w, scr, kb * 64, lane); continue; } r -= I_G;
        if (r < I_G) { const int kb = r / 88, nb = r % 88, c0 = nb * 32; tr_item(w_up, 2816, 1024, c0, Wgu_t, (c0 >> 7) * 256 + 128 + (c0 & 127), norm2_w, scr, kb * 64, lane); continue; } r -= I_G;
        { const int kb = r / 32, nb = r % 32; tr_item(w_down, 1024, 2816, nb * 32, Wdn_t, nb * 32, nullptr, scr, kb * 64, lane); }
    }
    float* wdt = (float*)lds;
    for (int idx = tid; idx < 16384; idx += 512) { const int col = idx >> 4, o = idx & 15; wdt[o * 1024 + col] = w_in[(size_t)col * 3088 + 3072 + o] * norm1_w[col]; }
    __syncthreads();
    const float* xp = p.in[0]; const float* xs = p.in[1]; const float* dtbf = p.in[9]; const float* dtbb = p.in[10];
    bf16* XN = (bf16*)(p.ws + WS_XN); float* DT = (float*)(p.ws + WS_DT);
    f32x4 vn[4];
    { const float* xr = gw < MP ? xp + (size_t)gw * 1024 : xs + (size_t)(gw - MP) * 1024;
#pragma unroll
        for (int j = 0; j < 4; ++j) vn[j] = ((const f32x4*)xr)[64 * j + lane]; }
    const int oidx = ((lane >> 5) & 1) * 8 + ((lane >> 4) & 1) * 4 + ((lane >> 3) & 1) * 2 + ((lane >> 2) & 1);
    const float obias = oidx < 8 ? dtbf[oidx] : dtbb[oidx - 8];
    for (int row = gw; row < M; row += NGW) {
        f32x4 v[4]; float ss = 0.f;
#pragma unroll
        for (int j = 0; j < 4; ++j) { v[j] = vn[j]; ss += (v[j].x * v[j].x + v[j].y * v[j].y) + (v[j].z * v[j].z + v[j].w * v[j].w); }
        { const int nrow = row + NGW;
            if (nrow < M) { const float* xr = nrow < MP ? xp + (size_t)nrow * 1024 : xs + (size_t)(nrow - MP) * 1024;
#pragma unroll
                for (int j = 0; j < 4; ++j) vn[j] = ((const f32x4*)xr)[64 * j + lane]; } }
        const float rstd = rsqrtf(wave_sum(ss) * (1.f / 1024.f) + EPS);
#pragma unroll
        for (int j = 0; j < 4; ++j) { v[j] = v[j] * rstd; u32x2 o; o.x = pk2(v[j].x, v[j].y); o.y = pk2(v[j].z, v[j].w); ((u32x2*)(XN + (size_t)row * 1024))[64 * j + lane] = o; }
        float part[16];
#pragma unroll
        for (int o = 0; o < 16; ++o) { float acc = 0.f;
#pragma unroll
            for (int j = 0; j < 4; ++j) { const f32x4 w = *(const f32x4*)(wdt + o * 1024 + 256 * j + 4 * lane); acc += (v[j].x * w.x + v[j].y * w.y) + (v[j].z * w.z + v[j].w * w.w); }
            part[o] = acc; }
        float r8[8], r4[4], r2[2];
#pragma unroll
        for (int o = 0; o < 8; ++o) { const bool hi = (lane & 32) != 0; const float send = hi ? part[o] : part[o + 8], keep = hi ? part[o + 8] : part[o]; r8[o] = keep + __shfl_xor(send, 32); }
#pragma unroll
        for (int o = 0; o < 4; ++o) { const bool hi = (lane & 16) != 0; const float send = hi ? r8[o] : r8[o + 4], keep = hi ? r8[o + 4] : r8[o]; r4[o] = keep + __shfl_xor(send, 16); }
#pragma unroll
        for (int o = 0; o < 2; ++o) { const bool hi = (lane & 8) != 0; const float send = hi ? r4[o] : r4[o + 2], keep = hi ? r4[o + 2] : r4[o]; r2[o] = keep + __shfl_xor(send, 8); }
        float r1; { const bool hi = (lane & 4) != 0; const float send = hi ? r2[0] : r2[1], keep = hi ? r2[1] : r2[0]; r1 = keep + __shfl_xor(send, 4); }
        r1 += __shfl_xor(r1, 1); r1 += __shfl_xor(r1, 2);
        if ((lane & 3) == 0) { const float x = r1 + obias; DT[(size_t)row * 16 + oidx] = fmaxf(x, 0.f) + log1pf(__expf(-fabsf(x))); }
    }
}

__device__ __forceinline__ void conv_load(const Params& p, int u, int tid, bf16x8 (&pre)[3], float& wpre) {
    const int c = u >> 4, sb = u & 15, t0 = c * 128;
    wpre = 0.f; if (tid < 320) wpre = p.in[7][(tid >> 6) * 1024 + sb * 64 + (tid & 63)]; else if (tid < 384) wpre = p.in[8][sb * 64 + (tid - 320)];
    const bool first = (c < 128) ? ((c & 63) == 0) : (((c - 128) & 15) == 0);
    const bool last = (c < 128) ? ((c & 63) == 63) : (((c - 128) & 15) == 15);
    const bf16* XBC = (const bf16*)(p.ws + WS_XBC);
#pragma unroll
    for (int k = 0; k < 3; ++k) { const int idx = tid + 512 * k; const int rr = idx >> 3, seg = idx & 7; const int t = t0 - 2 + rr;
        const bool ok = (idx < 132 * 8) && (rr >= 2 || !first) && (rr < 130 || !last);
        bf16x8 v = {0, 0, 0, 0, 0, 0, 0, 0}; if (ok) v = *(const bf16x8*)(XBC + (size_t)t * 1024 + sb * 64 + seg * 8);
        pre[k] = v; }
}
__device__ __forceinline__ void conv_unit(const Params& p, unsigned char* lds, int u, int unext, int tid, bf16x8 (&pre)[3], float& wpre) {
    const int c = u >> 4, sb = u & 15, t0 = c * 128;
    float* raw = (float*)lds;
#pragma unroll
    for (int k = 0; k < 3; ++k) { const int idx = tid + 512 * k; const int rr = idx >> 3, seg = idx & 7;
        if (idx < 132 * 8) {
#pragma unroll
            for (int j = 0; j < 8; ++j) raw[rr * 65 + seg * 8 + j] = bf2f((unsigned short)pre[k][j]); } }
    float* wl = raw + 132 * 65;
    if (tid < 384) wl[tid] = wpre;
    __syncthreads();
    if (unext < 384 * 16) conv_load(p, unext, tid, pre, wpre);
    unsigned char* dout = (unsigned char*)p.out;
    {
        const int ch = tid & 63, l0 = (tid >> 6) * 16;
        const float w0 = wl[ch], w1 = wl[64 + ch], w2 = wl[128 + ch], w3 = wl[192 + ch], w4 = wl[256 + ch], b = wl[320 + ch];
        float rv[20];
#pragma unroll
        for (int k = 0; k < 20; ++k) rv[k] = raw[(l0 + k) * 65 + ch];
        float ov[16];
#pragma unroll
        for (int j = 0; j < 16; ++j) ov[j] = silu(b + rv[j] * w0 + rv[j + 1] * w1 + rv[j + 2] * w2 + rv[j + 3] * w3 + rv[j + 4] * w4);
        if (sb >= 8) {
            bf16* dst = ((sb < 12) ? (bf16*)(dout + DO_BROW) + (sb - 8) * 64 + ch : (bf16*)(dout + DO_CROW) + (sb - 12) * 64 + ch) + (size_t)(t0 + l0) * 256;
#pragma unroll
            for (int j = 0; j < 16; ++j) dst[(size_t)j * 256] = f2bf(ov[j]);
        }
        if (sb < 12) {
            bf16* dstT = ((sb < 8) ? (bf16*)(dout + DO_XT) + (size_t)(c * 8 + sb) * 8192 + ch * 128
                                   : (bf16*)(dout + DO_BT) + ((size_t)(c * 2 + ((sb - 8) >> 1)) * 128 + ((sb - 8) & 1) * 64 + ch) * 128) + l0;
            u32x4 o0, o1;
            o0.x = pk2(ov[0], ov[1]); o0.y = pk2(ov[2], ov[3]); o0.z = pk2(ov[4], ov[5]); o0.w = pk2(ov[6], ov[7]);
            o1.x = pk2(ov[8], ov[9]); o1.y = pk2(ov[10], ov[11]); o1.z = pk2(ov[12], ov[13]); o1.w = pk2(ov[14], ov[15]);
            *(u32x4*)dstT = o0; *(u32x4*)(dstT + 8) = o1;
        }
    }
    __syncthreads();
}

__device__ __forceinline__ void phase2(const Params& p, unsigned char* lds, int tid, int lane, int wave, int G) {
    { bf16x8 pre[3]; float wpre; conv_load(p, blockIdx.x, tid, pre, wpre);
      for (int u = blockIdx.x; u < 384 * 16; u += G) conv_unit(p, lds, u, u + G, tid, pre, wpre); }
    const int gw = blockIdx.x * 8 + wave, NGW = G * 8;
    bf16* QK = (bf16*)(p.ws + WS_QK); const float* qw = p.in[4]; const float* kw = p.in[5];
    for (int row0 = gw; row0 < M; row0 += 4 * NGW) {
        bf16x8 vv[4][2];
#pragma unroll
        for (int r = 0; r < 4; ++r)
#pragma unroll
            for (int pass = 0; pass < 2; ++pass) { const int row = row0 + r * NGW; if (row < M) vv[r][pass] = *(const bf16x8*)(QK + (size_t)row * 1024 + pass * 512 + lane * 8); }
#pragma unroll
        for (int r = 0; r < 4; ++r)
#pragma unroll
            for (int pass = 0; pass < 2; ++pass) { const int row = row0 + r * NGW; if (row >= M) continue;
                float f[8]; float ss = 0.f;
#pragma unroll
                for (int j = 0; j < 8; ++j) { f[j] = bf2f((unsigned short)vv[r][pass][j]); ss += f[j] * f[j]; }
                ss += __shfl_xor(ss, 1); ss += __shfl_xor(ss, 2); ss += __shfl_xor(ss, 4);
                const float rstd = rsqrtf(ss * (1.f / 64.f) + EPS) * (pass == 0 ? 0.125f : 1.f);
                const float* w = (pass ? kw : qw) + (lane & 7) * 8;
#pragma unroll
                for (int j = 0; j < 8; ++j) f[j] = f[j] * rstd * w[j];
                *(bf16x8*)(QK + (size_t)row * 1024 + pass * 512 + lane * 8) = pack8(f); }
    }
    const bf16* VZ = (const bf16*)(p.ws + WS_VZ); bf16* VT = (bf16*)((unsigned char*)p.out + DO_VT);
    unsigned short* scr = (unsigned short*)(lds + 65536 + wave * 8448);
    for (int it = gw; it < 768 * 8; it += NGW) { const int R = it >> 3, h = it & 7;
        const bf16* src = VZ + (size_t)(R * 64 + lane) * 1024 + h * 64;
#pragma unroll
        for (int seg = 0; seg < 8; ++seg) { const bf16x8 v = *(const bf16x8*)(src + seg * 8);
#pragma unroll
            for (int j = 0; j < 8; ++j) scr[lane * 66 + seg * 8 + j] = (unsigned short)v[j]; }
        LDS_WAIT();
#pragma unroll
        for (int seg = 0; seg < 8; ++seg) { u32x4 o;
            o.x = (unsigned)scr[(seg * 8 + 0) * 66 + lane] | ((unsigned)scr[(seg * 8 + 1) * 66 + lane] << 16);
            o.y = (unsigned)scr[(seg * 8 + 2) * 66 + lane] | ((unsigned)scr[(seg * 8 + 3) * 66 + lane] << 16);
            o.z = (unsigned)scr[(seg * 8 + 4) * 66 + lane] | ((unsigned)scr[(seg * 8 + 5) * 66 + lane] << 16);
            o.w = (unsigned)scr[(seg * 8 + 6) * 66 + lane] | ((unsigned)scr[(seg * 8 + 7) * 66 + lane] << 16);
            *(u32x4*)(VT + ((size_t)it * 64 + lane) * 64 + seg * 8) = o; }
        LDS_WAIT();
    }
}
__device__ __forceinline__ void attn_unit(const Params& p, const float* rpbs, unsigned short* ost, int R, int h, int qbs, int lane) {
    const bf16* QK = (const bf16*)(p.ws + WS_QK); const bf16* VT = (const bf16*)((const unsigned char*)p.out + DO_VT); bf16* MIX = (bf16*)(p.ws + WS_MIX);
    int r, rows; if (R < 256) { r = R & 127; rows = 128; } else { r = (R - 256) & 31; rows = 32; }
    const int Rb = R - r;
    int r0 = r - 4; r0 = r0 < 0 ? 0 : r0; r0 = r0 > rows - 8 ? rows - 8 : r0;
    const int fr = lane & 15, quad = lane >> 4;
    for (int qb = qbs; qb < qbs + 2; ++qb) {
        const int kc0 = (qb == 0) ? 0 : (qb == 1 ? 8 : (qb == 2 ? 24 : 32));
        const int qc = qb * 16 + fr;
        const bf16* qp = QK + (size_t)(R * 64 + qc) * 1024 + h * 64 + quad * 8;
        bf16x8 qf0 = *(const bf16x8*)qp, qf1 = *(const bf16x8*)(qp + 32); mfma_operand_pad(qf0); mfma_operand_pad(qf1);
        f32x4 st[8][2];
#pragma unroll
        for (int i = 0; i < 8; ++i)
#pragma unroll
            for (int t = 0; t < 2; ++t) { const int kcm = kc0 + (fr >> 2) * 8 + 4 * t + (fr & 3);
                const bf16* kp = QK + (size_t)((Rb + r0 + i) * 64 + kcm) * 1024 + 512 + h * 64 + quad * 8;
                bf16x8 k0 = *(const bf16x8*)kp, k1 = *(const bf16x8*)(kp + 32); mfma_operand_pad(k0); mfma_operand_pad(k1);
                f32x4 a = {0.f, 0.f, 0.f, 0.f}; a = mfma16(k0, qf0, a); a = mfma16(k1, qf1, a); st[i][t] = a; }
        int c0q = qc - 8; c0q = c0q < 0 ? 0 : c0q; c0q = c0q > 48 ? 48 : c0q;
        float mx = -1e30f;
#pragma unroll
        for (int i = 0; i < 8; ++i)
#pragma unroll
            for (int t = 0; t < 2; ++t)
#pragma unroll
                for (int e = 0; e < 4; ++e) { const int kc = kc0 + quad * 8 + 4 * t + e; const bool valid = (kc >= c0q) && (kc < c0q + 16);
                    int dc = kc - qc + 15; dc = dc < 0 ? 0 : dc; dc = dc > 30 ? 30 : dc;
                    const float bv = rpbs[(h * 15 + (r0 + i - r + 7)) * 31 + dc];
                    float s = st[i][t][e] + bv; s = valid ? s : -1e30f; st[i][t][e] = s; mx = fmaxf(mx, s); }
        mx = fmaxf(mx, __shfl_xor(mx, 16)); mx = fmaxf(mx, __shfl_xor(mx, 32));
        float sum = 0.f;
#pragma unroll
        for (int i = 0; i < 8; ++i)
#pragma unroll
            for (int t = 0; t < 2; ++t)
#pragma unroll
                for (int e = 0; e < 4; ++e) { const float pe = __expf(st[i][t][e] - mx); st[i][t][e] = pe; sum += pe; }
        sum += __shfl_xor(sum, 16); sum += __shfl_xor(sum, 32);
        const float inv = 1.f / sum;
        f32x4 o[4];
#pragma unroll
        for (int dt = 0; dt < 4; ++dt) o[dt] = (f32x4){0.f, 0.f, 0.f, 0.f};
#pragma unroll
        for (int i = 0; i < 8; ++i) {
            float pv[8];
#pragma unroll
            for (int e = 0; e < 4; ++e) { pv[e] = st[i][0][e] * inv; pv[4 + e] = st[i][1][e] * inv; }
            bf16x8 pf = pack8(pv); mfma_operand_pad(pf);
#pragma unroll
            for (int dt = 0; dt < 4; ++dt) { const bf16* vp = VT + ((size_t)((Rb + r0 + i) * 8 + h) * 64 + dt * 16 + fr) * 64 + kc0 + quad * 8;
                bf16x8 vf = *(const bf16x8*)vp; mfma_operand_pad(vf); o[dt] = mfma16(pf, vf, o[dt]); }
        }
#pragma unroll
        for (int dt = 0; dt < 4; ++dt)
#pragma unroll
            for (int e = 0; e < 4; ++e) ost[(quad * 4 + e) * 72 + dt * 16 + fr] = f2bf(o[dt][e]);
        LDS_WAIT();
#pragma unroll
        for (int k = 0; k < 2; ++k) { const int row = k * 8 + (lane >> 3), ch = lane & 7;
            *(u32x4*)(MIX + (size_t)(R * 64 + qb * 16 + row) * 1024 + h * 64 + ch * 8) = *(const u32x4*)(ost + row * 72 + ch * 8); }
        LDS_WAIT();
    }
}

__device__ __forceinline__ void s1_unit(const Params& p, float* wts, int u, int lane, int wave) {
    const int c = u >> 3, h = u & 7, g = h >> 2, t0 = c * 128;
    const float* DT = (const float*)(p.ws + WS_DT); float* CDEC = (float*)(p.ws + WS_CDEC);
    bf16x8 bfa[4];
    { const bf16* btp = (const bf16*)((const unsigned char*)p.out + DO_BT) + ((size_t)(c * 2 + g) * 128 + wave * 16 + (lane & 15)) * 128 + (lane >> 4) * 8;
#pragma unroll
        for (int ks = 0; ks < 4; ++ks) bfa[ks] = *(const bf16x8*)(btp + ks * 32); }
    if (wave < 2) { const int dir = wave;
        const float A = -__expf(dir ? p.in[12][h] : p.in[11][h]);
        const float d0 = DT[(size_t)(t0 + 2 * lane) * 16 + dir * 8 + h], d1 = DT[(size_t)(t0 + 2 * lane + 1) * 16 + dir * 8 + h];
        const float a0 = d0 * A, a1 = d1 * A; float p0, p1, tot; wave_scan2(a0, a1, lane, p0, p1, tot);
        float w0, w1;
        if (dir == 0) { w0 = __expf(tot - p0) * d0; w1 = __expf(tot - p1) * d1; }
        else { w0 = __expf(p0 - a0) * d0; w1 = __expf(p1 - a1) * d1; }
        wts[dir * 128 + 2 * lane] = w0; wts[dir * 128 + 2 * lane + 1] = w1;
        if (lane == 0) CDEC[((dir * 384 + c) * 8 + h) * 32] = __expf(tot);
    }
    PG8_LAS unsigned char* xtl = (PG8_LAS unsigned char*)(wts + 4096) + 2 * 64 * 136 * 2 + 2048;
    { const bf16* xsrc = (const bf16*)((const unsigned char*)p.out + DO_XT) + (size_t)(c * 8 + h) * 8192;
#pragma unroll
        for (int k = 0; k < 2; ++k) { const int q = wave * 2 + k, row = q * 4 + (lane >> 4);
            __builtin_amdgcn_global_load_lds((const unsigned*)(xsrc + row * 128 + (((lane & 15) ^ (row & 15)) * 8)), (PG8_LAS unsigned*)(xtl + q * 1024), 16, 0, 0); }
        asm volatile("s_waitcnt vmcnt(0)" ::: "memory"); }
    __syncthreads();
    const int fr = lane & 15, quad = lane >> 4;
    const bf16* XT = (const bf16*)((const unsigned char*)p.out + DO_XT); const bf16* BT = (const bf16*)((const unsigned char*)p.out + DO_BT);
    bf16* STATE = (bf16*)(p.ws + WS_XN);
    f32x4 acc[2][4];
#pragma unroll
    for (int d = 0; d < 2; ++d)
#pragma unroll
        for (int pt = 0; pt < 4; ++pt) acc[d][pt] = (f32x4){0.f, 0.f, 0.f, 0.f};
#pragma unroll
    for (int ks = 0; ks < 4; ++ks) {
        bf16x8 bfr = bfa[ks]; mfma_operand_pad(bfr);
        const f32x4 wf0 = *(const f32x4*)(wts + ks * 32 + quad * 8), wf1 = *(const f32x4*)(wts + ks * 32 + quad * 8 + 4);
        const f32x4 wb0 = *(const f32x4*)(wts + 128 + ks * 32 + quad * 8), wb1 = *(const f32x4*)(wts + 128 + ks * 32 + quad * 8 + 4);
#pragma unroll
        for (int pt = 0; pt < 4; ++pt) {
            const bf16x8 xf = *(const PG8_LAS bf16x8*)(xtl + (pt * 16 + fr) * 256 + (((ks * 4 + quad) ^ fr) * 16));
            float xv[8], sf[8], sb[8];
#pragma unroll
            for (int j = 0; j < 8; ++j) xv[j] = bf2f((unsigned short)xf[j]);
#pragma unroll
            for (int j = 0; j < 4; ++j) { sf[j] = xv[j] * wf0[j]; sf[4 + j] = xv[4 + j] * wf1[j]; sb[j] = xv[j] * wb0[j]; sb[4 + j] = xv[4 + j] * wb1[j]; }
            bf16x8 af = pack8(sf), ab = pack8(sb); mfma_operand_pad(af); mfma_operand_pad(ab);
            acc[0][pt] = mfma16(af, bfr, acc[0][pt]);
            acc[1][pt] = mfma16(ab, bfr, acc[1][pt]);
        }
    }
    unsigned short* stg = (unsigned short*)(wts + 4096);
#pragma unroll
    for (int d = 0; d < 2; ++d)
#pragma unroll
        for (int pt = 0; pt < 4; ++pt)
#pragma unroll
            for (int e = 0; e < 4; ++e) stg[(d * 64 + pt * 16 + quad * 4 + e) * 136 + wave * 16 + fr] = f2bf(acc[d][pt][e]);
    __syncthreads();
    { const int tid = wave * 64 + lane;
#pragma unroll
        for (int i = 0; i < 4; ++i) { const int piece = tid + 512 * i, row = piece >> 4, seg = piece & 15, d = row >> 6, pr = row & 63;
            const u32x4 v = *(const u32x4*)(stg + row * 136 + seg * 8);
            *(u32x4*)(STATE + ((((size_t)d * 384 + c) * 8 + h) * 64 + pr) * 128 + seg * 8) = v; } }
    __syncthreads();
}

__device__ __forceinline__ void phase_scan(const Params& p, int tid, int G) {
    bf16* STATE = (bf16*)(p.ws + WS_XN); const float* CDEC = (const float*)(p.ws + WS_CDEC);
    for (int gt = blockIdx.x * 512 + tid; gt < 131072; gt += G * 512) {
        if (gt < 65536) {
            const int e4 = gt & 2047, h = (gt >> 11) & 7, sd = gt >> 14, sq = sd & 1, dir = sd >> 1, c0 = sq * 64;
            const int cstep = dir ? -1 : 1, cfirst = dir ? c0 + 63 : c0;
            u32x2* base = (u32x2*)(STATE + ((size_t)dir * 384 * 8 + h) * 8192 + e4 * 4);
            const float* dbase = CDEC + (dir * 384 * 8 + h) * 32;
            float hs[4] = {0.f, 0.f, 0.f, 0.f};
            u32x2 qv[8]; float qd[8];
#pragma unroll
            for (int j = 0; j < 8; ++j) { const int c = cfirst + cstep * j; qv[j] = base[(size_t)c * 16384]; qd[j] = dbase[c * 256]; }
#pragma unroll 1
            for (int s0 = 0; s0 < 64; s0 += 8) {
#pragma unroll
                for (int j = 0; j < 8; ++j) { const int c = cfirst + cstep * (s0 + j);
                    const u32x2 v = qv[j]; const float dec = qd[j];
                    if (s0 + 8 < 64) { const int cn = c + cstep * 8; qv[j] = base[(size_t)cn * 16384]; qd[j] = dbase[cn * 256]; }
                    u32x2 o; o.x = pk2(hs[0], hs[1]); o.y = pk2(hs[2], hs[3]); base[(size_t)c * 16384] = o;
                    hs[0] = hs[0] * dec + bf2f(v.x & 0xffffu); hs[1] = hs[1] * dec + bf2f(v.x >> 16); hs[2] = hs[2] * dec + bf2f(v.y & 0xffffu); hs[3] = hs[3] * dec + bf2f(v.y >> 16); }
            }
        } else {
            const int k = gt - 65536;
            float hs[4][8];
#pragma unroll
            for (int j = 0; j < 4; ++j)
#pragma unroll
                for (int i = 0; i < 8; ++i) hs[j][i] = 0.f;
            bf16* cb[4]; const float* db[4]; int cstep[4];
#pragma unroll
            for (int j = 0; j < 4; ++j) { const int it = k + 65536 * j, e8 = it & 1023, h = (it >> 10) & 7, sd = it >> 13, dir = sd >> 4, c0 = 128 + (sd & 15) * 16;
                const int cf = dir ? c0 + 15 : c0; cstep[j] = dir ? -1 : 1;
                cb[j] = STATE + (((size_t)dir * 384 + cf) * 8 + h) * 8192 + e8 * 8; db[j] = CDEC + ((dir * 384 + cf) * 8 + h) * 32; }
            bf16x8 qv[2][4]; float qd[2][4];
#pragma unroll
            for (int d = 0; d < 2; ++d)
#pragma unroll
                for (int j = 0; j < 4; ++j) { qv[d][j] = *(const bf16x8*)(cb[j] + (ptrdiff_t)cstep[j] * d * 65536); qd[d][j] = db[j][cstep[j] * d * 256]; }
#pragma unroll 1
            for (int s0 = 0; s0 < 16; s0 += 2) {
#pragma unroll
                for (int d = 0; d < 2; ++d)
#pragma unroll
                    for (int j = 0; j < 4; ++j) { const int st = s0 + d;
                        const bf16x8 v = qv[d][j]; const float dec = qd[d][j];
                        if (s0 + 2 < 16) { qv[d][j] = *(const bf16x8*)(cb[j] + (ptrdiff_t)cstep[j] * (st + 2) * 65536); qd[d][j] = db[j][cstep[j] * (st + 2) * 256]; }
                        *(bf16x8*)(cb[j] + (ptrdiff_t)cstep[j] * st * 65536) = pack8(hs[j]);
#pragma unroll
                        for (int i = 0; i < 8; ++i) hs[j][i] = hs[j][i] * dec + bf2f((unsigned short)v[i]); }
            }
        }
    }
}

__device__ __forceinline__ void s3_unit(const Params& p, unsigned char* lds, int u, int lane, int wave) {
    const int c = u >> 1, g = u & 1, t0 = c * 128;
    float* acsf = (float*)lds; float* rcsb = acsf + 512; float* dtf = acsf + 1024; float* dtb = acsf + 1536;
    const float* DT = (const float*)(p.ws + WS_DT);
    { const int hl = wave & 3, dir = wave >> 2, h = g * 4 + hl;
        const float A = -__expf(dir ? p.in[12][h] : p.in[11][h]);
        const float d0 = DT[(size_t)(t0 + 2 * lane) * 16 + dir * 8 + h], d1 = DT[(size_t)(t0 + 2 * lane + 1) * 16 + dir * 8 + h];
        const float a0 = d0 * A, a1 = d1 * A; float p0, p1, tot; wave_scan2(a0, a1, lane, p0, p1, tot);
        if (dir == 0) { acsf[hl * 128 + 2 * lane] = p0; acsf[hl * 128 + 2 * lane + 1] = p1; dtf[hl * 128 + 2 * lane] = d0; dtf[hl * 128 + 2 * lane + 1] = d1; }
        else { rcsb[hl * 128 + 2 * lane] = tot - p0 + a0; rcsb[hl * 128 + 2 * lane + 1] = tot - p1 + a1; dtb[hl * 128 + 2 * lane] = d0; dtb[hl * 128 + 2 * lane + 1] = d1; }
    }
    __syncthreads();
    const int fr = lane & 15, quad = lane >> 4, lrow = 16 * wave + fr, l4 = 16 * wave + quad * 4;
    const unsigned char* dout = (const unsigned char*)p.out;
    const bf16* XT = (const bf16*)(dout + DO_XT); const bf16* BROW = (const bf16*)(dout + DO_BROW); const bf16* CROW = (const bf16*)(dout + DO_CROW);
    const bf16* STATE = (const bf16*)(p.ws + WS_XN); const bf16* VZ = (const bf16*)(p.ws + WS_VZ); bf16* MIX = (bf16*)(p.ws + WS_MIX);
    bf16x8 cf[4];
#pragma unroll
    for (int ks = 0; ks < 4; ++ks) { cf[ks] = *(const bf16x8*)(CROW + (size_t)(t0 + lrow) * 256 + g * 128 + ks * 32 + quad * 8); mfma_operand_pad(cf[ks]); }
    PG8_LAS unsigned char* tlb = (PG8_LAS unsigned char*)lds + 74240;
#pragma unroll
    for (int k = 0; k < 4; ++k) { const int q = wave * 4 + k, row = q * 4 + (lane >> 4);
        __builtin_amdgcn_global_load_lds((const unsigned*)(BROW + (size_t)(t0 + row) * 256 + g * 128 + (((lane & 15) ^ (row & 15)) * 8)), (PG8_LAS unsigned*)(tlb + q * 1024), 16, 0, 0); }
    asm volatile("s_waitcnt vmcnt(0)" ::: "memory");
    __syncthreads();
    f32x4 cb[4][2];
#pragma unroll
    for (int sp = 0; sp < 4; ++sp)
#pragma unroll
        for (int t = 0; t < 2; ++t) { const int srow = sp * 32 + (fr >> 2) * 8 + 4 * t + (fr & 3);
            f32x4 a = {0.f, 0.f, 0.f, 0.f};
#pragma unroll
            for (int ks = 0; ks < 4; ++ks) a = mfma16(*(const PG8_LAS bf16x8*)(tlb + srow * 256 + (((ks * 4 + quad) ^ (srow & 15)) * 16)), cf[ks], a);
            cb[sp][t] = a; }
    float ssq[4] = {0.f, 0.f, 0.f, 0.f};
    unsigned short* gsm = (unsigned short*)(lds + 8192 + wave * 8192);
    float* rsm = (float*)(lds + 8192 + 8 * 8192) + wave * 16;
    PG8_LAS unsigned char* tl = (PG8_LAS unsigned char*)lds + 74240;
    const int dj = lane >> 4;
    const int dcp = lane & 15;
    const float* nw = p.in[14];
#pragma unroll 1
    for (int hl = 0; hl < 4; ++hl) { const int h = g * 4 + hl;
        const bf16* xth = XT + (size_t)(c * 8 + h) * 8192;
        const bf16* stf = STATE + ((size_t)c * 8 + h) * 8192; const bf16* stb = stf + (size_t)384 * 8 * 8192;
        __syncthreads();
#pragma unroll
        for (int k = 0; k < 2; ++k) { const int row = (wave * 2 + k) * 4 + dj; const int so = row * 128 + ((dcp ^ (row & 15)) * 8);
            __builtin_amdgcn_global_load_lds((const unsigned*)(xth + so), (PG8_LAS unsigned*)(tl + (wave * 2 + k) * 1024), 16, 0, 0);
            __builtin_amdgcn_global_load_lds((const unsigned*)(stf + so), (PG8_LAS unsigned*)(tl + 16384 + (wave * 2 + k) * 1024), 16, 0, 0);
            __builtin_amdgcn_global_load_lds((const unsigned*)(stb + so), (PG8_LAS unsigned*)(tl + 32768 + (wave * 2 + k) * 1024), 16, 0, 0); }
        asm volatile("s_waitcnt vmcnt(0)" ::: "memory");
        __syncthreads();
        const float af_l = acsf[hl * 128 + lrow], rb_l = rcsb[hl * 128 + lrow];
        f32x4 Y[4];
        {
            f32x4 Yf[4], Yb[4];
#pragma unroll
            for (int pt = 0; pt < 4; ++pt) { Yf[pt] = (f32x4){0.f, 0.f, 0.f, 0.f}; Yb[pt] = Yf[pt]; }
#pragma unroll
            for (int ks = 0; ks < 4; ++ks) {
#pragma unroll
                for (int pt = 0; pt < 4; ++pt) {
                    const int lo = (pt * 16 + fr) * 256 + (((ks * 4 + quad) ^ fr) * 16);
                    Yf[pt] = mfma16(cf[ks], *(const PG8_LAS bf16x8*)(tl + 16384 + lo), Yf[pt]);
                    Yb[pt] = mfma16(cf[ks], *(const PG8_LAS bf16x8*)(tl + 32768 + lo), Yb[pt]);
                }
            }
            const f32x4 ea = *(const f32x4*)(acsf + hl * 128 + l4), eb = *(const f32x4*)(rcsb + hl * 128 + l4);
            f32x4 xa, xb;
#pragma unroll
            for (int e = 0; e < 4; ++e) { xa[e] = __expf(ea[e]); xb[e] = __expf(eb[e]); }
#pragma unroll
            for (int pt = 0; pt < 4; ++pt) Y[pt] = xa * Yf[pt] + xb * Yb[pt];
        }
#pragma unroll
        for (int sp = 0; sp < 4; ++sp) { const int s0 = sp * 32 + quad * 8;
            float mv[8];
#pragma unroll
            for (int t = 0; t < 2; ++t) {
                const f32x4 afs = *(const f32x4*)(acsf + hl * 128 + s0 + 4 * t), rbs = *(const f32x4*)(rcsb + hl * 128 + s0 + 4 * t);
                const f32x4 dfs = *(const f32x4*)(dtf + hl * 128 + s0 + 4 * t), dbs = *(const f32x4*)(dtb + hl * 128 + s0 + 4 * t);
#pragma unroll
                for (int e = 0; e < 4; ++e) { const int s = s0 + 4 * t + e;
                    const float ef = __expf(fminf(af_l - afs[e], 0.f)) * dfs[e], eb2 = __expf(fminf(rb_l - rbs[e], 0.f)) * dbs[e];
                    const float vf = (s <= lrow) ? ef : 0.f;
                    const float vb = (s >= lrow) ? eb2 : 0.f;
                    mv[4 * t + e] = cb[sp][t][e] * (vf + vb); }
            }
            bf16x8 mf = pack8(mv); mfma_operand_pad(mf);
#pragma unroll
            for (int pt = 0; pt < 4; ++pt) Y[pt] = mfma16(mf, *(const PG8_LAS bf16x8*)(tl + (pt * 16 + fr) * 256 + (((sp * 4 + quad) ^ fr) * 16)), Y[pt]);
        }
        const float Dk = p.in[13][h];
#pragma unroll
        for (int pt = 0; pt < 4; ++pt) { const int pc = pt * 16 + fr;
            const u32x2 xw = *(const u32x2*)(xth + (size_t)pc * 128 + l4);
            const float xv[4] = {bf2f(xw.x & 0xffffu), bf2f(xw.x >> 16), bf2f(xw.y & 0xffffu), bf2f(xw.y >> 16)};
            const float wn = nw[h * 64 + pc];
#pragma unroll
            for (int e = 0; e < 4; ++e) { const size_t off = (size_t)(t0 + l4 + e) * 1024 + 512 + h * 64 + pc;
                const float zv = bf2f(VZ[off]);
                const float y = Y[pt][e] + Dk * xv[e];
                const float gg = y * silu(zv); ssq[e] += gg * gg;
                gsm[(quad * 4 + e) * 256 + hl * 64 + pc] = f2bf(gg * wn); }
        }
    }
#pragma unroll
    for (int e = 0; e < 4; ++e) { float ss = ssq[e];
        ss += __shfl_xor(ss, 1); ss += __shfl_xor(ss, 2); ss += __shfl_xor(ss, 4); ss += __shfl_xor(ss, 8);
        if (fr == 0) rsm[quad * 4 + e] = rsqrtf(ss * (1.f / 256.f) + EPS); }
    LDS_WAIT();
    { const int r = lane >> 2; const float rs = rsm[r];
        bf16* mp = MIX + (size_t)(t0 + 16 * wave + r) * 1024 + 512 + g * 256 + (lane & 3) * 64;
        const unsigned short* gp = gsm + r * 256 + (lane & 3) * 64;
#pragma unroll
        for (int it = 0; it < 8; ++it) { const u32x4 w = *(const u32x4*)(gp + it * 8);
            u32x4 o; o.x = pk2(bf2f(w.x & 0xffffu) * rs, bf2f(w.x >> 16) * rs); o.y = pk2(bf2f(w.y & 0xffffu) * rs, bf2f(w.y >> 16) * rs);
            o.z = pk2(bf2f(w.z & 0xffffu) * rs, bf2f(w.z >> 16) * rs); o.w = pk2(bf2f(w.w & 0xffffu) * rs, bf2f(w.w >> 16) * rs);
            *(u32x4*)(mp + it * 8) = o; }
    }
    __syncthreads();
}
using pg8::Unit;
struct EpiProj {
    static constexpr bool PERM = true, AFTER_DRAIN = false;
    bf16* O;
    __device__ __forceinline__ void operator()(const f32x4 (&acc)[2][2][4][2], const Unit& u, int wr, int wc, int fr, int fq) const {
        const int row0 = u.pm * 256 + wr * 64 + fr; const int colt = u.pn * 256; const int piece = colt >> 10;
        bf16* base = O + (size_t)piece * ((size_t)M * 1024) + (colt & 1023) + wc * 32 + 8 * fq;
#pragma unroll
        for (int ai = 0; ai < 2; ++ai)
#pragma unroll
            for (int m = 0; m < 4; ++m) { bf16* rowp = base + (size_t)(row0 + ai * 128 + m * 16) * 1024;
#pragma unroll
                for (int bj = 0; bj < 2; ++bj) { const f32x4 v0 = acc[ai][bj][m][0], v1 = acc[ai][bj][m][1];
                    u32x4 w; w.x = pk2(v0[0], v0[1]); w.y = pk2(v0[2], v0[3]); w.z = pk2(v1[0], v1[1]); w.w = pk2(v1[2], v1[3]);
                    *(u32x4*)(rowp + bj * 128) = w; } }
    }
};
struct EpiOut {
    static constexpr bool PERM = true, AFTER_DRAIN = false;
    const float* xp; const float* xs; float* out; bf16* xb; float* rowss;
    __device__ __forceinline__ void operator()(const f32x4 (&acc)[2][2][4][2], const Unit& u, int wr, int wc, int fr, int fq) const {
        const int row0 = u.pm * 256 + wr * 64 + fr; const int col0 = u.pn * 256 + wc * 32 + 8 * fq;
#pragma unroll
        for (int ai = 0; ai < 2; ++ai)
#pragma unroll
            for (int m = 0; m < 4; ++m) { const int row = row0 + ai * 128 + m * 16;
                const float* xr = (row < MP ? xp + (size_t)row * 1024 : xs + (size_t)(row - MP) * 1024) + col0;
                float ss = 0.f;
#pragma unroll
                for (int bj = 0; bj < 2; ++bj) {
                    const f32x4 v0 = acc[ai][bj][m][0] + *(const f32x4*)(xr + bj * 128), v1 = acc[ai][bj][m][1] + *(const f32x4*)(xr + bj * 128 + 4);
                    u32x4 w; w.x = pk2(v0[0], v0[1]); w.y = pk2(v0[2], v0[3]); w.z = pk2(v1[0], v1[1]); w.w = pk2(v1[2], v1[3]);
                    *(u32x4*)(xb + (size_t)row * 1024 + col0 + bj * 128) = w;
                    ss += (v0[0] * v0[0] + v0[1] * v0[1]) + (v0[2] * v0[2] + v0[3] * v0[3]) + (v1[0] * v1[0] + v1[1] * v1[1]) + (v1[2] * v1[2] + v1[3] * v1[3]); }
                ss += __shfl_xor(ss, 16); ss += __shfl_xor(ss, 32);
                if (fq == 0) rowss[((size_t)u.pn * M + row) * 4 + wc] = ss; }
    }
};
struct EpiGU {
    static constexpr bool PERM = true, AFTER_DRAIN = false;
    bf16* hid; const float* rowss;
    __device__ __forceinline__ void operator()(const f32x4 (&acc)[2][2][4][2], const Unit& u, int wr, int wc, int fr, int fq) const {
        const int row0 = u.pm * 256 + wr * 64 + fr; const int col0 = u.pn * 128 + wc * 32 + 8 * fq;
#pragma unroll
        for (int ai = 0; ai < 2; ++ai)
#pragma unroll
            for (int m = 0; m < 4; ++m) { const int row = row0 + ai * 128 + m * 16;
                const f32x4* pp = (const f32x4*)(rowss + (size_t)row * 4); const f32x4 q0 = pp[0], q1 = pp[M], q2 = pp[2 * M], q3 = pp[3 * M];
                const float rsum = ((q0[0] + q0[1]) + (q0[2] + q0[3])) + ((q1[0] + q1[1]) + (q1[2] + q1[3])) + ((q2[0] + q2[1]) + (q2[2] + q2[3])) + ((q3[0] + q3[1]) + (q3[2] + q3[3]));
                const float rstd = rsqrtf(rsum * (1.f / 1024.f) + EPS);
                float hv[8];
#pragma unroll
                for (int n = 0; n < 2; ++n)
#pragma unroll
                    for (int e = 0; e < 4; ++e) { const float gt = acc[ai][0][m][n][e] * rstd, up = acc[ai][1][m][n][e] * rstd; hv[4 * n + e] = silu(gt) * up; }
                *(bf16x8*)(hid + (size_t)row * 2816 + col0) = pack8(hv); }
    }
};
struct EpiDown {
    static constexpr bool PERM = true, AFTER_DRAIN = false;
    float* out; const bf16* xb;
    __device__ __forceinline__ void operator()(const f32x4 (&acc)[2][2][4][2], const Unit& u, int wr, int wc, int fr, int fq) const {
        const int row0 = u.pm * 256 + wr * 64 + fr; const int col0 = u.pn * 256 + wc * 32 + 8 * fq;
#pragma unroll
        for (int ai = 0; ai < 2; ++ai)
#pragma unroll
            for (int m = 0; m < 4; ++m) { const size_t off = (size_t)(row0 + ai * 128 + m * 16) * 1024 + col0;
#pragma unroll
                for (int bj = 0; bj < 2; ++bj) { const u32x4 w = *(const u32x4*)(xb + off + bj * 128);
                    f32x4 a0, a1; a0[0] = bf2f(w.x & 0xffffu); a0[1] = bf2f(w.x >> 16); a0[2] = bf2f(w.y & 0xffffu); a0[3] = bf2f(w.y >> 16);
                    a1[0] = bf2f(w.z & 0xffffu); a1[1] = bf2f(w.z >> 16); a1[2] = bf2f(w.w & 0xffffu); a1[3] = bf2f(w.w >> 16);
                    *(f32x4*)(out + off + bj * 128) = a0 + acc[ai][bj][m][0]; *(f32x4*)(out + off + bj * 128 + 4) = a1 + acc[ai][bj][m][1]; } }
    }
};

#define LAS __attribute__((address_space(3)))
#define XB_TMO      128
#define XB_XCNT(j)  (256  + 64 * (j))
#define XB_XSUB(j)  (1280 + 64 * (j))
#define XB_XGEN(j)  (2304 + 64 * (j))
#define XB_TOP      3328
#define XB_TOPGEN   3392
#define XCD_BAR_WORDS 3456
#define XB_SPIN_CAP (1u << 18)

__device__ __forceinline__ unsigned xb_ld(unsigned* p)              { return __hip_atomic_load(p, __ATOMIC_RELAXED, __HIP_MEMORY_SCOPE_AGENT); }
__device__ __forceinline__ unsigned xb_add(unsigned* p, unsigned v) { return __hip_atomic_fetch_add(p, v, __ATOMIC_RELAXED, __HIP_MEMORY_SCOPE_AGENT); }
__device__ __forceinline__ unsigned xb_xcc_id() { return (unsigned)__builtin_amdgcn_s_getreg((3 << 11) | 20) & 0xFu; }
#define XB_SPIN(cond, bar) do { unsigned _sp = 0; while (cond) { __builtin_amdgcn_s_sleep(1); \
    if ((++_sp & 255u) == 0u) { if (xb_ld(&(bar)[XB_TMO])) break; if (_sp > XB_SPIN_CAP) { atomicAdd(&(bar)[XB_TMO], 1u); break; } } } } while (0)

struct XcdBarrier {
    unsigned* bar; unsigned x;
    volatile LAS unsigned* st;
};

__device__ __forceinline__ XcdBarrier xcd_barrier_post(unsigned* bar, volatile LAS unsigned* st) {
    XcdBarrier b; b.bar = bar; b.x = xb_xcc_id(); b.st = st;
    if (threadIdx.x == 0) (void)xb_add(&bar[XB_XCNT(b.x)], 1u);
    return b;
}
__device__ __forceinline__ void xcd_barrier_complete(unsigned* bar, unsigned x, unsigned& nloc, unsigned& nx) {
    const unsigned G = gridDim.x * gridDim.y * gridDim.z;
    unsigned sum, cnt, mine, sp = 0u;
    for (;;) {
        sum = 0u; cnt = 0u; mine = 0u;
#pragma unroll
        for (unsigned j = 0; j < 16; ++j) { const unsigned c = xb_ld(&bar[XB_XCNT(j)]); sum += c; cnt += (c > 0u) ? 1u : 0u; mine = (j == x) ? c : mine; }
        if (sum == G) break;
        __builtin_amdgcn_s_sleep(1);
        if ((++sp & 255u) == 0u) { if (xb_ld(&bar[XB_TMO])) break; if (sp > XB_SPIN_CAP) { atomicAdd(&bar[XB_TMO], 1u); break; } }
    }
    nloc = mine > 0u ? mine : 1u; nx = cnt > 0u ? cnt : 1u;
}

__device__ __forceinline__ void xcd_barrier(const XcdBarrier& b) {
    asm volatile("s_waitcnt vmcnt(0)" ::: "memory");
    __syncthreads();
    if (threadIdx.x == 0) {
        unsigned* bar = b.bar;
        __builtin_amdgcn_s_waitcnt(0);
        unsigned nloc = b.st[0], nx = b.st[1];
        if (nloc == 0u) { xcd_barrier_complete(bar, b.x, nloc, nx); b.st[0] = nloc; b.st[1] = nx; }
        const unsigned old = xb_add(&bar[XB_XSUB(b.x)], 1u);
        const unsigned gen = old / nloc;
        if (old + 1u == (gen + 1u) * nloc) {
            __builtin_amdgcn_fence(__ATOMIC_RELEASE, "agent");
            asm volatile("s_waitcnt vmcnt(0)" ::: "memory");
            const unsigned og = xb_add(&bar[XB_TOP], 1u);
            const unsigned tg = og / nx;
            if (og + 1u == (tg + 1u) * nx) xb_add(&bar[XB_TOPGEN], 1u);
            else XB_SPIN(xb_ld(&bar[XB_TOPGEN]) == tg, bar);
            __builtin_amdgcn_fence(__ATOMIC_ACQUIRE, "agent");
            xb_add(&bar[XB_XGEN(b.x)], 1u);
            asm volatile("s_waitcnt vmcnt(0)" ::: "memory");
        } else {
            XB_SPIN(xb_ld(&bar[XB_XGEN(b.x)]) == gen, bar);
            __builtin_amdgcn_fence(__ATOMIC_ACQUIRE, "agent");
            asm volatile("s_waitcnt vmcnt(0)" ::: "memory");
        }
    }
    __syncthreads();
}


__device__ __forceinline__ void gsync(cg::grid_group& grid) {
    asm volatile("s_waitcnt vmcnt(0) lgkmcnt(0)" ::: "memory");
    __syncthreads();
    grid.sync();
    __builtin_amdgcn_fence(__ATOMIC_ACQUIRE, "agent");
    asm volatile("s_waitcnt vmcnt(0)" ::: "memory");
    __syncthreads();
}
constexpr int LDS_BYTES = 147456;
__global__ void __launch_bounds__(512, 2) hymba_fwd(Params p) {
    extern __shared__ __attribute__((aligned(16))) unsigned char lds[];
    cg::grid_group grid = cg::this_grid();
    const int tid = threadIdx.x, lane = tid & 63, wave = __builtin_amdgcn_readfirstlane(tid >> 6), G = gridDim.x;
    PG8_LAS unsigned char* glds = (PG8_LAS unsigned char*)lds;
    volatile LAS unsigned* MISC = (volatile LAS unsigned*)((LAS unsigned char*)lds + (LDS_BYTES - 64));
    if (tid < 16) MISC[tid] = 0u;
    unsigned* barw = (unsigned*)(p.ws + WS_BAR);
    if (blockIdx.x == 0) for (int i = tid; i < XCD_BAR_WORDS; i += 512) __hip_atomic_store(barw + i, 0u, __ATOMIC_RELAXED, __HIP_MEMORY_SCOPE_AGENT);
    __syncthreads();

#ifndef SKIP_P0
    phase0(p, lds, tid, lane, wave, G);
#endif
    gsync(grid);
    const XcdBarrier xbar = xcd_barrier_post(barw, MISC + 8);
#ifndef SKIP_P1
    { pg8::Gemm g{(const bf16*)(p.ws + WS_XN), (const bf16*)(p.ws + WS_WIN), M, 3072, 1024}; pg8::StaticOrder S; S.init(M, 3072, G, (int)blockIdx.x);
      EpiProj E{(bf16*)(p.ws + WS_QK)};
      pg8::gemm_phase<EpiProj, pg8::StaticOrder, true, true>(glds, g, S, E); }
#endif
    xcd_barrier(xbar);
#ifndef SKIP_P2
    phase2(p, lds, tid, lane, wave, G);
#endif
    xcd_barrier(xbar);
    { float* rpbs = (float*)lds; float* wts = (float*)(lds + 16384);
      for (int i = tid; i < 8 * 15 * 31; i += 512) rpbs[i] = p.in[6][i];
      __syncthreads();
#ifndef SKIP_P3A
      const int vcu = (G % 8 == 0) ? (int)(blockIdx.x % 8) * (G / 8) + (int)(blockIdx.x / 8) : (int)blockIdx.x;
      for (int U = vcu; U < 1536; U += G) attn_unit(p, rpbs, (unsigned short*)(lds + 86016 + wave * 2304), U >> 1, (U & 1) * 4 + (wave & 3), (wave >> 2) * 2, lane);
#endif
#ifndef SKIP_P3B
      for (int u = vcu; u < 384 * 8; u += G) s1_unit(p, wts, u, lane, wave);
#endif
    }
    xcd_barrier(xbar);
#ifndef SKIP_P4
    phase_scan(p, tid, G);
#endif
    xcd_barrier(xbar);
#ifndef SKIP_P5
    for (int u = blockIdx.x; u < 768; u += G) s3_unit(p, lds, u, lane, wave);
#endif
    xcd_barrier(xbar);
#ifndef SKIP_P6
    { pg8::Gemm g{(const bf16*)(p.ws + WS_MIX), (const bf16*)(p.ws + WS_WOUT), M, 1024, 1024}; pg8::StaticOrder S; S.init(M, 1024, G, (int)blockIdx.x);
      EpiOut E{p.in[0], p.in[1], p.out, (bf16*)(p.ws + WS_XN), (float*)(p.ws + WS_PART)};
      pg8::gemm_phase<EpiOut, pg8::StaticOrder, true, true>(glds, g, S, E); }
#endif
    xcd_barrier(xbar);
#ifndef SKIP_P7
    { pg8::Gemm g{(const bf16*)(p.ws + WS_XN), (const bf16*)(p.ws + WS_WGU), M, 5632, 1024}; pg8::StaticOrder S; S.init(M, 5632, G, (int)blockIdx.x);
      EpiGU E{(bf16*)(p.ws + WS_HID), (const float*)(p.ws + WS_PART)};
      pg8::gemm_phase<EpiGU, pg8::StaticOrder, true, true>(glds, g, S, E); }
#endif
    xcd_barrier(xbar);
#ifndef SKIP_P8
    { pg8::Gemm g{(const bf16*)(p.ws + WS_HID), (const bf16*)(p.ws + WS_WDN), M, 1024, 2816}; pg8::StaticOrder S; S.init(M, 1024, G, (int)blockIdx.x);
      EpiDown E{p.out, (const bf16*)(p.ws + WS_XN)};
      pg8::gemm_phase<EpiDown, pg8::StaticOrder, true, true>(glds, g, S, E); }
#endif
}
}

extern "C" void kernel_launch(void* const* d_in, const int* in_sizes, int n_in, void* d_out, int out_size, void* d_ws, size_t ws_size, hipStream_t stream) {
    static int grid = 0;
    if (grid == 0) {
        if (n_in != 20 || out_size != hk::M * 1024 || ws_size < hk::WS_END) { fprintf(stderr, "kernel_launch: unexpected shapes (n_in %d out %d ws %zu)\n", n_in, out_size, ws_size); grid = -1; return; }
        int dev = 0, cus = 0, per_cu = 0;
        if (hipGetDevice(&dev) != hipSuccess || hipDeviceGetAttribute(&cus, hipDeviceAttributeMultiprocessorCount, dev) != hipSuccess) { grid = -1; return; }
        if (hipFuncSetAttribute((const void*)hk::hymba_fwd, hipFuncAttributeMaxDynamicSharedMemorySize, hk::LDS_BYTES) != hipSuccess) { fprintf(stderr, "kernel_launch: hipFuncSetAttribute failed\n"); grid = -1; return; }
        if (hipOccupancyMaxActiveBlocksPerMultiprocessor(&per_cu, (const void*)hk::hymba_fwd, 512, hk::LDS_BYTES) != hipSuccess || per_cu < 1) { fprintf(stderr, "kernel_launch: occupancy query says %d\n", per_cu); (void)hipGetLastError(); grid = -1; return; }
        grid = cus * 1;
    }
    if (grid < 0) return;
    hk::Params prm{};
    for (int i = 0; i < 20; ++i) prm.in[i] = (const float*)d_in[i];
    prm.out = (float*)d_out; prm.ws = (unsigned char*)d_ws;
    void* args[] = {&prm};
    hipError_t e = hipLaunchCooperativeKernel((const void*)hk::hymba_fwd, dim3(grid), dim3(512), args, hk::LDS_BYTES, stream);
    if (e != hipSuccess) fprintf(stderr, "cooperative launch failed: %s (grid %d)\n", hipGetErrorString(e), grid);
}
```
